# Optimizing an MI355X kernel written in HIP

```python
import math
import jax, jax.numpy as jnp
from jax import lax
import numpy as np

D_MODEL = 1024
BATCH = 4
SEQ = 4096
DEPTH = 1

D_MIX = D_MODEL
HGRN_W = D_MIX // 2
CONV_W = D_MIX - HGRN_W
HGRN_HEADS = 4
HGRN_DV = HGRN_W // HGRN_HEADS
HGRN_DK = 128
HGRN_F = HGRN_HEADS * HGRN_DK
CONV_GROUPS = 8
CONV_K = 3
CHUNK = 64
MEM_LEN = 256
MEM_HEADS = 4
MEM_HD = D_MODEL // MEM_HEADS
D_FF = int(math.ceil(8 * D_MODEL / 3 / 256) * 256)
EPS = 1e-6
IN_COLS = 3 * HGRN_F // HGRN_F * 0 + HGRN_F + HGRN_F + HGRN_W + HGRN_W + 3 * CONV_W

kernel_name = "hybrid_hgrn2_shortconv_macaron_memxattn"


def rms_norm(x, g):
    xf = x.astype(jnp.float32)
    y = xf * lax.rsqrt(jnp.mean(xf * xf, axis=-1, keepdims=True) + EPS)
    return (y * g.astype(jnp.float32)).astype(x.dtype)


def swiglu(h, w_gate, w_up, w_down):
    return (jax.nn.silu(h @ w_gate) * (h @ w_up)) @ w_down


def hgrn2_chunkwise(q, k, v, logf):
    b_, s_, h_, dk = q.shape
    dv = v.shape[-1]
    n = s_ // CHUNK

    def to_chunks(t):
        return t.astype(jnp.float32).reshape(b_, n, CHUNK, h_, t.shape[-1]).transpose(1, 0, 3, 2, 4)

    qc, kc, vc, lc = to_chunks(q), to_chunks(k), to_chunks(v), to_chunks(logf)
    bc = jnp.cumsum(lc, axis=-2)
    causal = jnp.tril(jnp.ones((CHUNK, CHUNK), dtype=bool))[None, None, :, :, None]

    def step(state, inp):
        qi, ki, vi, bi = inp
        diff = bi[:, :, :, None, :] - bi[:, :, None, :, :]
        decay = jnp.exp(jnp.where(causal, diff, -jnp.inf))
        scores = jnp.einsum('bhtk,bhsk,bhtsk->bhts', qi, ki, decay)
        o = jnp.einsum('bhts,bhsv->bhtv', scores, vi) + \
            jnp.einsum('bhtk,bhkv->bhtv', qi * jnp.exp(bi), state)
        b_last = bi[:, :, -1:, :]
        new_state = jnp.exp(b_last[:, :, 0, :])[..., None] * state + \
            jnp.einsum('bhsk,bhsv->bhkv', ki * jnp.exp(b_last - bi), vi)
        return new_state, o

    s0 = jnp.zeros((b_, h_, dk, dv), jnp.float32)
    _, o = lax.scan(step, s0, (qc, kc, vc, bc))
    return o.transpose(1, 0, 3, 2, 4).reshape(b_, s_, h_, dv)


def causal_depthwise_conv(u, w):
    s_ = u.shape[1]
    up = jnp.pad(u, ((0, 0), (CONV_K - 1, 0), (0, 0)))
    return sum(w[:, j] * up[:, j:j + s_, :] for j in range(CONV_K))


def setup_inputs(seed: int = 0) -> dict:
    key = jax.random.key(seed)
    ks = jax.random.split(key, 24)
    L = DEPTH

    def w(k, shape, fan_in):
        return jax.random.normal(k, shape, jnp.float32) * fan_in ** -0.5

    def gain(k, shape):
        return 1.0 + 0.02 * jax.random.normal(k, shape, jnp.float32)

    return {
        "x": jax.random.normal(ks[0], (BATCH, SEQ, D_MODEL), jnp.float32),
        "mem": jax.random.normal(ks[1], (BATCH, MEM_LEN, D_MODEL), jnp.float32),
        "ffn1_norm": gain(ks[2], (L, D_MODEL)),
        "ffn1_gate": w(ks[3], (L, D_MODEL, D_FF), D_MODEL),
        "ffn1_up": w(ks[4], (L, D_MODEL, D_FF), D_MODEL),
        "ffn1_down": w(ks[5], (L, D_FF, D_MODEL), D_FF),
        "mix_norm": gain(ks[6], (L, D_MODEL)),
        "w_in": w(ks[7], (L, D_MODEL, IN_COLS), D_MODEL),
        "lb_param": 0.1 * jax.random.normal(ks[8], (L + 1, HGRN_F), jnp.float32),
        "hgrn_out_norm": gain(ks[9], (L, HGRN_W)),
        "conv_w": w(ks[10], (L, CONV_W, CONV_K), CONV_K),
        "w_out": w(ks[11], (L, D_MIX, D_MODEL), D_MIX),
        "xattn_norm": gain(ks[12], (L, D_MODEL)),
        "mem_norm": gain(ks[13], (L, D_MODEL)),
        "w_q_mem": w(ks[14], (L, D_MODEL, D_MODEL), D_MODEL),
        "w_kv_mem": w(ks[15], (L, D_MODEL, 2 * D_MODEL), D_MODEL),
        "w_o_mem": w(ks[16], (L, D_MODEL, D_MODEL), D_MODEL),
        "ffn2_norm": gain(ks[17], (L, D_MODEL)),
        "ffn2_gate": w(ks[18], (L, D_MODEL, D_FF), D_MODEL),
        "ffn2_up": w(ks[19], (L, D_MODEL, D_FF), D_MODEL),
        "ffn2_down": w(ks[20], (L, D_FF, D_MODEL), D_FF),
        "final_norm": gain(ks[21], (D_MODEL,)),
    }


def reference(x, mem, ffn1_norm, ffn1_gate, ffn1_up, ffn1_down, mix_norm, w_in,
              lb_param, hgrn_out_norm, conv_w, w_out, xattn_norm, mem_norm,
              w_q_mem, w_kv_mem, w_o_mem, ffn2_norm, ffn2_gate, ffn2_up,
              ffn2_down, final_norm):
    b_, s_, _ = x.shape
    lb_all = jnp.cumsum(jax.nn.softmax(lb_param.astype(jnp.float32), axis=0), axis=0)

    for l in range(DEPTH):
        x = x + 0.5 * swiglu(rms_norm(x, ffn1_norm[l]), ffn1_gate[l], ffn1_up[l], ffn1_down[l])

        h = rms_norm(x, mix_norm[l])
        z = h @ w_in[l]
        o1 = HGRN_F; o2 = o1 + HGRN_F; o3 = o2 + HGRN_W; o4 = o3 + HGRN_W
        o5 = o4 + CONV_W; o6 = o5 + CONV_W
        zq, zf, zi, zg = z[..., :o1], z[..., o1:o2], z[..., o2:o3], z[..., o3:o4]
        zb, zc, zu = z[..., o4:o5], z[..., o5:o6], z[..., o6:]

        lb = lb_all[l]
        f = lb + (1.0 - lb) * jax.nn.sigmoid(zf.astype(jnp.float32))
        logf = jnp.log(f)
        kk = 1.0 - f
        q = jax.nn.silu(zq.astype(jnp.float32)) * HGRN_DK ** -0.5
        shp_k = (b_, s_, HGRN_HEADS, HGRN_DK)
        o_h = hgrn2_chunkwise(q.reshape(shp_k), kk.reshape(shp_k),
                              zi.reshape(b_, s_, HGRN_HEADS, HGRN_DV), logf.reshape(shp_k))
        g_h = hgrn_out_norm[l].astype(jnp.float32).reshape(HGRN_HEADS, HGRN_DV)
        o_h = o_h * lax.rsqrt(jnp.mean(o_h * o_h, axis=-1, keepdims=True) + EPS) * g_h
        y_hgrn = (o_h.reshape(b_, s_, HGRN_W) * jax.nn.silu(zg.astype(jnp.float32))).astype(x.dtype)

        y_conv = zb * causal_depthwise_conv(zc * zu, conv_w[l])

        x = x + jnp.concatenate([y_hgrn, y_conv.astype(x.dtype)], axis=-1) @ w_out[l]

        hq = rms_norm(x, xattn_norm[l])
        mn = rms_norm(mem, mem_norm[l])
        qm = (hq @ w_q_mem[l]).reshape(b_, s_, MEM_HEADS, MEM_HD)
        kv = mn @ w_kv_mem[l]
        km = kv[..., :D_MODEL].reshape(b_, MEM_LEN, MEM_HEADS, MEM_HD)
        vm = kv[..., D_MODEL:].reshape(b_, MEM_LEN, MEM_HEADS, MEM_HD)
        sc = jnp.einsum('bshd,bmhd->bhsm', qm.astype(jnp.float32), km.astype(jnp.float32)) * MEM_HD ** -0.5
        p = jax.nn.softmax(sc, axis=-1)
        att = jnp.einsum('bhsm,bmhd->bshd', p, vm.astype(jnp.float32)).astype(x.dtype)
        x = x + att.reshape(b_, s_, D_MODEL) @ w_o_mem[l]

        x = x + 0.5 * swiglu(rms_norm(x, ffn2_norm[l]), ffn2_gate[l], ffn2_up[l], ffn2_down[l])

    return rms_norm(x, final_norm)
```

```cpp
#include <hip/hip_runtime.h>
#include <cstdio>
#include <cstdint>

#define GAS __attribute__((address_space(1)))
#define LAS __attribute__((address_space(3)))
typedef unsigned short bf16;
typedef unsigned v4u __attribute__((ext_vector_type(4)));
typedef unsigned v2u __attribute__((ext_vector_type(2)));
typedef float f32x4 __attribute__((ext_vector_type(4)));

constexpr int BATCH = 4, SEQ = 4096, D = 1024, M = BATCH * SEQ, DFF = 2816, NGU = 2 * DFF, INC = 3584;
constexpr int HF = 512, NH = 4, DK = 128, DV = 128, CHUNK = 64, NCHUNK = SEQ / CHUNK;
constexpr int MEML = 256, MH = 4, MHD = 256, MROWS = BATCH * MEML;
constexpr float EPS = 1e-6f;
constexpr int NWAVES = 8, NTHR = NWAVES * 64;
constexpr int NPHASE = 17;

constexpr size_t MiB = 1u << 20;
constexpr size_t WS_CTL = 0, CTL_ZERO_BYTES = 1 * MiB;
constexpr size_t WS_LB = 1 * MiB, WS_RS = 1 * MiB + 65536;
constexpr size_t WS_WGU1 = 2 * MiB, WS_WD1 = 13 * MiB, WS_WIN = WS_WD1 + 5 * MiB + 512 * 1024, WS_WOUT = WS_WIN + 7 * MiB, WS_WQ = WS_WOUT + 2 * MiB,
                 WS_WKV = WS_WQ + 2 * MiB, WS_WO = WS_WKV + 4 * MiB, WS_WGU2 = WS_WO + 2 * MiB, WS_WD2 = WS_WGU2 + 11 * MiB, WS_MN = 52 * MiB, WS_KM = 54 * MiB, WS_VMT = 56 * MiB,
                 WS_DEC = 58 * MiB;
static_assert(WS_WD2 + 5 * MiB + 512 * 1024 == WS_MN, "weight map");
constexpr size_t WS_XN = 64 * MiB, WS_HID = 96 * MiB, WS_XB = 216 * MiB;
constexpr size_t WS_Q = 64 * MiB, WS_KK = 80 * MiB, WS_LOGF = 96 * MiB, WS_V = 128 * MiB, WS_SG = 144 * MiB, WS_ZB = 160 * MiB, WS_P = 176 * MiB, WS_DS = 192 * MiB, WS_Y = 224 * MiB;
constexpr size_t WS_XB2 = 64 * MiB, WS_QM = 96 * MiB, WS_ATT = 128 * MiB, WS_END = 256 * MiB;

constexpr int RING_BYTES = 131072, LDSCTL_OFF = RING_BYTES, MISC_OFF = LDSCTL_OFF + 320, LDS_BYTES = 147456;

__device__ __forceinline__ unsigned f2bf(float f) { unsigned u = __builtin_bit_cast(unsigned, f); return (u + 0x7fffu + ((u >> 16) & 1u)) >> 16; }
__device__ __forceinline__ unsigned pk2(float lo, float hi) { return f2bf(lo) | (f2bf(hi) << 16); }
__device__ __forceinline__ float bflo(unsigned w) { return __builtin_bit_cast(float, w << 16); }
__device__ __forceinline__ float bfhi(unsigned w) { return __builtin_bit_cast(float, w & 0xffff0000u); }
__device__ __forceinline__ float bf2f(bf16 b) { return __builtin_bit_cast(float, (unsigned)b << 16); }
__device__ __forceinline__ float wave_sum(float v) {
#pragma unroll
    for (int o = 1; o < 64; o <<= 1) v += __shfl_xor(v, o);
    return v;
}
__device__ __forceinline__ float wave_max(float v) {
#pragma unroll
    for (int o = 1; o < 64; o <<= 1) v = fmaxf(v, __shfl_xor(v, o));
    return v;
}
__device__ __forceinline__ float silu_f(float x) { return x / (1.f + __expf(-x)); }
__device__ __forceinline__ float sigm_f(float x) { return 1.f / (1.f + __expf(-x)); }
__device__ __forceinline__ void unpack8(v4u w, float (&f)[8]) {
    f[0] = bflo(w.x); f[1] = bfhi(w.x); f[2] = bflo(w.y); f[3] = bfhi(w.y); f[4] = bflo(w.z); f[5] = bfhi(w.z); f[6] = bflo(w.w); f[7] = bfhi(w.w);
}
__device__ __forceinline__ v4u pack8(const float (&f)[8]) { v4u w; w.x = pk2(f[0], f[1]); w.y = pk2(f[2], f[3]); w.z = pk2(f[4], f[5]); w.w = pk2(f[6], f[7]); return w; }

struct Frame {
    LAS unsigned char* lds;
    int tid, lane, wave, vcu, G;
    long gtid, NT;
    int gw, NGW;
    const float* const* in; float* out; unsigned char* ws;
};

struct EmGU {
    bf16* HID; const float* RS;
    __device__ __forceinline__ void operator()(int row, int pn, int c8, const float (&a)[8], const float (&b)[8]) const {
        const float r = RS ? RS[row] : 1.f; float h[8];
#pragma unroll
        for (int j = 0; j < 8; ++j) h[j] = silu_f(r * a[j]) * (r * b[j]);
        *(v4u*)(HID + (size_t)row * DFF + 128 * pn + c8) = pack8(h);
    }
};
struct EmRes {
    const float* XIN; float* XF; bf16* XB; float scale;
    __device__ __forceinline__ void operator()(int row, int pn, int c8, const float (&a)[8], const float (&b)[8]) const {
#pragma unroll
        for (int hh = 0; hh < 2; ++hh) {
            const size_t off = (size_t)row * D + 256 * pn + 128 * hh + c8;
            const f32x4 x0 = *(const f32x4*)(XIN + off), x1 = *(const f32x4*)(XIN + off + 4);
            float o[8];
#pragma unroll
            for (int j = 0; j < 4; ++j) { o[j] = x0[j] + scale * (hh ? b[j] : a[j]); o[4 + j] = x1[j] + scale * (hh ? b[4 + j] : a[4 + j]); }
            *(f32x4*)(XF + off) = (f32x4){o[0], o[1], o[2], o[3]}; *(f32x4*)(XF + off + 4) = (f32x4){o[4], o[5], o[6], o[7]};
            if (XB) *(v4u*)(XB + off) = pack8(o);
        }
    }
};
struct EmIn {
    bf16 *Q, *KK, *V, *SG, *ZB, *P; float* LOGF; const float* RS; const float* LB;
    __device__ __forceinline__ void operator()(int row, int pn, int c8, const float (&a)[8], const float (&b)[8]) const {
        const float r = RS[row];
        if (pn >= 10) {
            float o[8];
#pragma unroll
            for (int j = 0; j < 8; ++j) o[j] = (r * a[j]) * (r * b[j]);
            *(v4u*)(P + (size_t)row * 512 + 128 * (pn - 10) + c8) = pack8(o);
            return;
        }
        const int kind = pn >> 1;
#pragma unroll
        for (int hh = 0; hh < 2; ++hh) {
            const int col = 256 * (pn & 1) + 128 * hh + c8; const size_t off = (size_t)row * 512 + col;
            float z[8], o[8];
#pragma unroll
            for (int j = 0; j < 8; ++j) z[j] = r * (hh ? b[j] : a[j]);
            if (kind == 0) {
#pragma unroll
                for (int j = 0; j < 8; ++j) o[j] = silu_f(z[j]) * 0.08838834764831845f;
                *(v4u*)(Q + off) = pack8(o);
            } else if (kind == 1) {
                float lf[8];
                const f32x4 l0 = *(const f32x4*)(LB + col), l1 = *(const f32x4*)(LB + col + 4);
#pragma unroll
                for (int j = 0; j < 8; ++j) { const float lb = j < 4 ? l0[j] : l1[j - 4]; const float f = lb + (1.f - lb) * sigm_f(z[j]); o[j] = 1.f - f; lf[j] = __logf(f); }
                *(v4u*)(KK + off) = pack8(o);
                *(f32x4*)(LOGF + off) = (f32x4){lf[0], lf[1], lf[2], lf[3]}; *(f32x4*)(LOGF + off + 4) = (f32x4){lf[4], lf[5], lf[6], lf[7]};
            } else if (kind == 2) { *(v4u*)(V + off) = pack8(z);
            } else if (kind == 3) {
#pragma unroll
                for (int j = 0; j < 8; ++j) o[j] = silu_f(z[j]);
                *(v4u*)(SG + off) = pack8(o);
            } else { *(v4u*)(ZB + off) = pack8(z); }
        }
    }
};
struct EmPlain {
    bf16* O; const float* RS; float scale;
    __device__ __forceinline__ void operator()(int row, int pn, int c8, const float (&a)[8], const float (&b)[8]) const {
        const float r = (RS ? RS[row] : 1.f) * scale; float o[8];
#pragma unroll
        for (int j = 0; j < 8; ++j) o[j] = r * a[j];
        *(v4u*)(O + (size_t)row * 1024 + 256 * pn + c8) = pack8(o);
#pragma unroll
        for (int j = 0; j < 8; ++j) o[j] = r * b[j];
        *(v4u*)(O + (size_t)row * 1024 + 256 * pn + 128 + c8) = pack8(o);
    }
};

template <class Emit>
__device__ __forceinline__ void naive_gemm(const Frame& F, const bf16* A, const bf16* Bt, int Mr, int N, int K, const Emit& E) {
    const long nitem = (long)Mr * (N / 256) * 16;
    for (long i = F.gtid; i < nitem; i += F.NT) {
        const int l = (int)(i & 63); const long g = i >> 6; const int rg = (int)(g % (Mr / 4)), pn = (int)(g / (Mr / 4));
        const int row = rg * 4 + (l >> 4), c8 = (l & 15) * 8;
        float a[8], b[8];
#pragma unroll
        for (int j = 0; j < 8; ++j) { a[j] = 0.f; b[j] = 0.f; }
        const bf16* ap = A + (size_t)row * K; const bf16* bp = Bt + (size_t)(256 * pn + c8) * K;
        for (int k = 0; k < K; k += 8) {
            float av[8]; unpack8(*(const v4u*)(ap + k), av);
#pragma unroll
            for (int j = 0; j < 8; ++j) {
                float bv[8]; unpack8(*(const v4u*)(bp + (size_t)j * K + k), bv);
                float cv[8]; unpack8(*(const v4u*)(bp + (size_t)(128 + j) * K + k), cv);
#pragma unroll
                for (int e = 0; e < 8; ++e) { a[j] += av[e] * bv[e]; b[j] += av[e] * cv[e]; }
            }
        }
        E(row, pn, c8, a, b);
    }
}

__device__ __forceinline__ void transpose_item(const float* W, int ldw, int col0, const float* g, bf16* WT, int Kd, int n0, int k0, LAS float* scr, int lane) {
#pragma unroll 8
    for (int i = 0; i < 32; ++i) { const int kk = 2 * i + (lane >> 5); const float gv = g ? g[k0 + kk] : 1.f; scr[kk * 33 + (lane & 31)] = W[(size_t)(k0 + kk) * ldw + col0 + (lane & 31)] * gv; }
    asm volatile("s_waitcnt lgkmcnt(0)" ::: "memory");
    const int c = lane & 7;
#pragma unroll
    for (int j = 0; j < 4; ++j) { const int n = (lane >> 3) + 8 * j; const LAS float* s = scr + (8 * c) * 33 + n;
        v4u o; o.x = pk2(s[0 * 33], s[1 * 33]); o.y = pk2(s[2 * 33], s[3 * 33]); o.z = pk2(s[4 * 33], s[5 * 33]); o.w = pk2(s[6 * 33], s[7 * 33]);
        *(v4u*)(WT + (size_t)(n0 + n) * Kd + k0 + 8 * c) = o; }
    asm volatile("s_waitcnt lgkmcnt(0)" ::: "memory");
}
__device__ __forceinline__ void norm_row_bf16(const float* xrow, const float* gain, bf16* orow, int lane) {
    const f32x4* xr = (const f32x4*)xrow + lane; f32x4 v[4]; float s = 0.f;
#pragma unroll
    for (int j = 0; j < 4; ++j) { v[j] = xr[64 * j]; s += (v[j].x * v[j].x + v[j].y * v[j].y) + (v[j].z * v[j].z + v[j].w * v[j].w); }
    const float r = 1.f / sqrtf(wave_sum(s) * (1.f / D) + EPS);
    v2u* o8 = (v2u*)orow + lane;
#pragma unroll
    for (int j = 0; j < 4; ++j) { f32x4 gg = gain ? ((const f32x4*)gain)[lane + 64 * j] : (f32x4){1.f, 1.f, 1.f, 1.f};
        v2u w; w.x = pk2(v[j].x * r * gg.x, v[j].y * r * gg.y); w.y = pk2(v[j].z * r * gg.z, v[j].w * r * gg.w); o8[64 * j] = w; }
}
__device__ __forceinline__ void p_prologue(const Frame& F) {
    LAS float* scr = (LAS float*)(F.lds + F.wave * 16384);
    unsigned char* ws = F.ws;
    constexpr int I_GU = 16 * (NGU / 32), I_D = (DFF / 64) * (D / 32), I_IN = 16 * (INC / 32), I_SQ = 16 * 32, I_KV = 16 * 64;
    constexpr int NITEMS = 2 * I_GU + 2 * I_D + I_IN + 3 * I_SQ + I_KV;
    for (int it = F.gw; it < NITEMS; it += F.NGW) {
        int r = it;
        if (r < 2 * I_GU) {
            const int which = r / I_GU; r -= which * I_GU; const int nb = r % (NGU / 32), kb = r / (NGU / 32), n0 = 32 * nb, t = n0 / 256, w = n0 % 256, half = w / 128, col = 128 * t + (w % 128);
            const float* W = F.in[(which ? 18 : 3) + half]; const float* g = F.in[which ? 17 : 2];
            transpose_item(W, DFF, col, g, (bf16*)(ws + (which ? WS_WGU2 : WS_WGU1)), D, n0, 64 * kb, scr, F.lane); continue; }
        r -= 2 * I_GU;
        if (r < 2 * I_D) { const int which = r / I_D; r -= which * I_D; const int nb = r % (D / 32), kb = r / (D / 32);
            transpose_item(F.in[which ? 20 : 5], D, 32 * nb, nullptr, (bf16*)(ws + (which ? WS_WD2 : WS_WD1)), DFF, 32 * nb, 64 * kb, scr, F.lane); continue; }
        r -= 2 * I_D;
        if (r < I_IN) { const int nb = r % (INC / 32), kb = r / (INC / 32), n0 = 32 * nb; int col = n0;
            if (n0 >= 2560) { const int t = (n0 - 2560) / 256, w = (n0 - 2560) % 256, half = w / 128; col = (half ? 3072 : 2560) + 128 * t + (w % 128); }
            transpose_item(F.in[7], INC, col, F.in[6], (bf16*)(ws + WS_WIN), D, n0, 64 * kb, scr, F.lane); continue; }
        r -= I_IN;
        if (r < 3 * I_SQ) { const int which = r / I_SQ; r -= which * I_SQ; const int nb = r % 32, kb = r / 32;
            const float* W = F.in[which == 0 ? 11 : (which == 1 ? 14 : 16)]; const float* g = which == 1 ? F.in[12] : nullptr;
            bf16* dst = (bf16*)(ws + (which == 0 ? WS_WOUT : (which == 1 ? WS_WQ : WS_WO)));
            transpose_item(W, D, 32 * nb, g, dst, D, 32 * nb, 64 * kb, scr, F.lane); continue; }
        r -= 3 * I_SQ;
        { const int nb = r % 64, kb = r / 64; transpose_item(F.in[15], 2 * D, 32 * nb, nullptr, (bf16*)(ws + WS_WKV), D, 32 * nb, 64 * kb, scr, F.lane); }
    }
    for (int m = F.gw; m < M; m += F.NGW) norm_row_bf16(F.in[0] + (size_t)m * D, nullptr, (bf16*)(ws + WS_XN) + (size_t)m * D, F.lane);
    for (int m = F.gw; m < MROWS; m += F.NGW) norm_row_bf16(F.in[1] + (size_t)m * D, F.in[13], (bf16*)(ws + WS_MN) + (size_t)m * D, F.lane);
    if (F.gtid < HF) { const float p0 = F.in[8][F.gtid], p1 = F.in[8][HF + F.gtid]; const float mx = fmaxf(p0, p1), e0 = __expf(p0 - mx), e1 = __expf(p1 - mx);
        ((float*)(ws + WS_LB))[F.gtid] = e0 / (e0 + e1); }
}

__device__ __forceinline__ void p_rowstat(const Frame& F) {
    float* RS = (float*)(F.ws + WS_RS);
    for (int m = F.gw; m < M; m += F.NGW) {
        const f32x4* xr = (const f32x4*)(F.out + (size_t)m * D) + F.lane; float s = 0.f;
#pragma unroll
        for (int j = 0; j < 4; ++j) { const f32x4 v = xr[64 * j]; s += (v.x * v.x + v.y * v.y) + (v.z * v.z + v.w * v.w); }
        s = wave_sum(s);
        if (F.lane == 0) RS[m] = 1.f / sqrtf(s * (1.f / D) + EPS);
    }
}
__device__ __forceinline__ void p_final(const Frame& F) {
    const float* g = F.in[21];
    for (int m = F.gw; m < M; m += F.NGW) {
        f32x4* xr = (f32x4*)(F.out + (size_t)m * D) + F.lane; f32x4 v[4]; float s = 0.f;
#pragma unroll
        for (int j = 0; j < 4; ++j) { v[j] = xr[64 * j]; s += (v[j].x * v[j].x + v[j].y * v[j].y) + (v[j].z * v[j].z + v[j].w * v[j].w); }
        const float r = 1.f / sqrtf(wave_sum(s) * (1.f / D) + EPS);
#pragma unroll
        for (int j = 0; j < 4; ++j) { const f32x4 gg = ((const f32x4*)g)[F.lane + 64 * j]; xr[64 * j] = (f32x4){v[j].x * r * gg.x, v[j].y * r * gg.y, v[j].z * r * gg.z, v[j].w * r * gg.w}; }
    }
}

__device__ __forceinline__ void p_conv(const Frame& F) {
    const bf16* ZB = (const bf16*)(F.ws + WS_ZB); const bf16* P = (const bf16*)(F.ws + WS_P); bf16* Y = (bf16*)(F.ws + WS_Y); const float* cw = F.in[10];
    const long nitem = (long)M * 64;
    for (long i = F.gtid; i < nitem; i += F.NT) {
        const int row = (int)(i >> 6), c8 = (int)(i & 63) * 8, t = row % SEQ;
        float zb[8], p0[8], p1[8], p2[8], o[8];
        unpack8(*(const v4u*)(ZB + (size_t)row * 512 + c8), zb);
        unpack8(*(const v4u*)(P + (size_t)row * 512 + c8), p2);
        if (t >= 1) unpack8(*(const v4u*)(P + (size_t)(row - 1) * 512 + c8), p1); else {
#pragma unroll
            for (int j = 0; j < 8; ++j) p1[j] = 0.f; }
        if (t >= 2) unpack8(*(const v4u*)(P + (size_t)(row - 2) * 512 + c8), p0); else {
#pragma unroll
            for (int j = 0; j < 8; ++j) p0[j] = 0.f; }
#pragma unroll
        for (int j = 0; j < 8; ++j) { const float* w = cw + (c8 + j) * 3; o[j] = zb[j] * (w[0] * p0[j] + w[1] * p1[j] + w[2] * p2[j]); }
        *(v4u*)(Y + (size_t)row * D + 512 + c8) = pack8(o);
    }
}

__device__ __forceinline__ void p_scan_simple(const Frame& F) {
    const bf16* Q = (const bf16*)(F.ws + WS_Q); const bf16* KK = (const bf16*)(F.ws + WS_KK); const bf16* V = (const bf16*)(F.ws + WS_V); const float* LOGF = (const float*)(F.ws + WS_LOGF);
    float* O32 = (float*)(F.ws + WS_DS);
    if (F.gtid < BATCH * NH * DV) {
    const int dv = (int)(F.gtid % DV), h = (int)(F.gtid / DV) % NH, b = (int)(F.gtid / (DV * NH));
    float S[DK];
#pragma unroll
    for (int i = 0; i < DK; ++i) S[i] = 0.f;
    for (int t = 0; t < SEQ; ++t) {
        const size_t rb = ((size_t)b * SEQ + t) * 512 + h * 128;
        const float v = bf2f(V[rb + dv]); float o = 0.f;
#pragma unroll
        for (int i8 = 0; i8 < DK / 8; ++i8) {
            float q[8], k[8]; unpack8(*(const v4u*)(Q + rb + 8 * i8), q); unpack8(*(const v4u*)(KK + rb + 8 * i8), k);
            const f32x4 l0 = *(const f32x4*)(LOGF + rb + 8 * i8), l1 = *(const f32x4*)(LOGF + rb + 8 * i8 + 4);
#pragma unroll
            for (int j = 0; j < 8; ++j) { const float f = __expf(j < 4 ? l0[j] : l1[j - 4]); S[8 * i8 + j] = f * S[8 * i8 + j] + k[j] * v; o += S[8 * i8 + j] * q[j]; }
        }
        O32[((size_t)b * SEQ + t) * 512 + h * 128 + dv] = o;
    }
    }
}
__device__ __forceinline__ void p_hnorm_simple(const Frame& F) {
    const float* O32 = (const float*)(F.ws + WS_DS); const bf16* SG = (const bf16*)(F.ws + WS_SG); bf16* Y = (bf16*)(F.ws + WS_Y); const float* g = F.in[9];
    for (int it = F.gw; it < M * NH; it += F.NGW) {
        const int row = it >> 2, h = it & 3; const size_t off = (size_t)row * 512 + h * 128 + 2 * F.lane;
        const float o0 = O32[off], o1 = O32[off + 1];
        const float r = 1.f / sqrtf(wave_sum(o0 * o0 + o1 * o1) * (1.f / DV) + EPS);
        const unsigned sg = *(const unsigned*)(SG + off);
        *(unsigned*)(Y + (size_t)row * D + h * 128 + 2 * F.lane) = pk2(o0 * r * g[h * 128 + 2 * F.lane] * bflo(sg), o1 * r * g[h * 128 + 2 * F.lane + 1] * bfhi(sg));
    }
}

__device__ __forceinline__ void p_attn_simple(const Frame& F) {
    const bf16* QM = (const bf16*)(F.ws + WS_QM); const bf16* KM = (const bf16*)(F.ws + WS_KM); const bf16* VMT = (const bf16*)(F.ws + WS_VMT); bf16* ATT = (bf16*)(F.ws + WS_ATT);
    const int lane = F.lane;
    for (int it = F.gw; it < M * MH; it += F.NGW) {
        const int row = it >> 2, h = it & 3, b = row / SEQ;
        const v2u qw = *(const v2u*)(QM + (size_t)row * D + h * MHD + 4 * lane);
        const float q0 = bflo(qw.x), q1 = bfhi(qw.x), q2 = bflo(qw.y), q3 = bfhi(qw.y);
        float sc[4];
#pragma unroll
        for (int jj = 0; jj < 4; ++jj) {
            float mine = 0.f;
            for (int jl = 0; jl < 64; ++jl) {
                const v2u kw = *(const v2u*)(KM + (size_t)(b * MEML + jj * 64 + jl) * D + h * MHD + 4 * lane);
                const float s = wave_sum(q0 * bflo(kw.x) + q1 * bfhi(kw.x) + q2 * bflo(kw.y) + q3 * bfhi(kw.y));
                if (lane == jl) mine = s;
            }
            sc[jj] = mine;
        }
        const float mx = wave_max(fmaxf(fmaxf(sc[0], sc[1]), fmaxf(sc[2], sc[3])));
        float l = 0.f;
#pragma unroll
        for (int jj = 0; jj < 4; ++jj) { sc[jj] = __expf(sc[jj] - mx); l += sc[jj]; }
        const float inv = 1.f / wave_sum(l);
        float acc[4] = {0.f, 0.f, 0.f, 0.f};
#pragma unroll
        for (int jj = 0; jj < 4; ++jj)
            for (int jc = 0; jc < 8; ++jc) {
                float p[8];
#pragma unroll
                for (int e = 0; e < 8; ++e) p[e] = __shfl(sc[jj], jc * 8 + e);
#pragma unroll
                for (int i = 0; i < 4; ++i) { float vv[8]; unpack8(*(const v4u*)(VMT + (size_t)(h * MHD + 4 * lane + i) * MROWS + b * MEML + jj * 64 + jc * 8), vv);
#pragma unroll
                    for (int e = 0; e < 8; ++e) acc[i] += p[e] * vv[e]; }
            }
        v2u o; o.x = pk2(acc[0] * inv, acc[1] * inv); o.y = pk2(acc[2] * inv, acc[3] * inv);
        *(v2u*)(ATT + (size_t)row * D + h * MHD + 4 * lane) = o;
    }
}

struct Args { const float* in[22]; float* out; unsigned char* ws; int ph_lo, ph_hi; };
__global__ void __launch_bounds__(NTHR, 2) fwd(Args args) {
    extern __shared__ __attribute__((aligned(16))) unsigned char lds[];
    Frame F;
    F.lds = (LAS unsigned char*)lds;
    F.tid = threadIdx.x; F.lane = F.tid & 63; F.wave = __builtin_amdgcn_readfirstlane(F.tid >> 6);
    F.G = gridDim.x; { const int bx = blockIdx.x; F.vcu = (F.G % 8 == 0) ? (bx % 8) * (F.G / 8) + bx / 8 : bx; }
    F.gtid = (long)F.vcu * NTHR + F.tid; F.NT = (long)F.G * NTHR; F.gw = F.vcu * NWAVES + F.wave; F.NGW = F.G * NWAVES;
    F.in = args.in;
    F.out = args.out; F.ws = args.ws;
    unsigned char* ws = args.ws;
    const int lo = args.ph_lo, hi = args.ph_hi;
#define IN(k) (lo <= (k) && (k) < hi)
    const float* RS = (const float*)(ws + WS_RS);
    if (IN(0)) p_prologue(F);
    if (IN(1)) {
        naive_gemm(F, (const bf16*)(ws + WS_XN), (const bf16*)(ws + WS_WGU1), M, NGU, D, EmGU{(bf16*)(ws + WS_HID), nullptr});
        naive_gemm(F, (const bf16*)(ws + WS_MN), (const bf16*)(ws + WS_WKV), MROWS, D, D, EmPlain{(bf16*)(ws + WS_KM), nullptr, 1.f});
        naive_gemm(F, (const bf16*)(ws + WS_WKV) + (size_t)D * D, (const bf16*)(ws + WS_MN), D, MROWS, D, EmPlain{(bf16*)(ws + WS_VMT), nullptr, 1.f});
    }
    if (IN(2)) naive_gemm(F, (const bf16*)(ws + WS_HID), (const bf16*)(ws + WS_WD1), M, D, DFF, EmRes{F.in[0], F.out, (bf16*)(ws + WS_XB), 0.5f});
    if (IN(3)) p_rowstat(F);
    if (IN(4)) naive_gemm(F, (const bf16*)(ws + WS_XB), (const bf16*)(ws + WS_WIN), M, INC, D,
                          EmIn{(bf16*)(ws + WS_Q), (bf16*)(ws + WS_KK), (bf16*)(ws + WS_V), (bf16*)(ws + WS_SG), (bf16*)(ws + WS_ZB), (bf16*)(ws + WS_P), (float*)(ws + WS_LOGF), RS, (const float*)(ws + WS_LB)});
    if (IN(5)) { p_conv(F); p_scan_simple(F); }
    if (IN(6)) {}
    if (IN(7)) p_hnorm_simple(F);
    if (IN(8)) naive_gemm(F, (const bf16*)(ws + WS_Y), (const bf16*)(ws + WS_WOUT), M, D, D, EmRes{F.out, F.out, (bf16*)(ws + WS_XB2), 1.f});
    if (IN(9)) p_rowstat(F);
    if (IN(10)) naive_gemm(F, (const bf16*)(ws + WS_XB2), (const bf16*)(ws + WS_WQ), M, D, D, EmPlain{(bf16*)(ws + WS_QM), RS, 0.0625f});
    if (IN(11)) p_attn_simple(F);
    if (IN(12)) naive_gemm(F, (const bf16*)(ws + WS_ATT), (const bf16*)(ws + WS_WO), M, D, D, EmRes{F.out, F.out, (bf16*)(ws + WS_XB2), 1.f});
    if (IN(13)) p_rowstat(F);
    if (IN(14)) naive_gemm(F, (const bf16*)(ws + WS_XB2), (const bf16*)(ws + WS_WGU2), M, NGU, D, EmGU{(bf16*)(ws + WS_HID), RS});
    if (IN(15)) naive_gemm(F, (const bf16*)(ws + WS_HID), (const bf16*)(ws + WS_WD2), M, D, DFF, EmRes{F.out, F.out, nullptr, 0.5f});
    if (IN(16)) p_final(F);
#undef IN
}

extern "C" void kernel_launch(void* const* d_in, const int* in_sizes, int n_in, void* d_out, int out_size, void* d_ws, size_t ws_size, hipStream_t stream) {
    static int grid = 0;
    if (grid == 0) {
        if (n_in != 22 || in_sizes[0] != M * D || out_size != M * D || ws_size < WS_END) { fprintf(stderr, "kernel_launch: unexpected shapes (n_in %d, in0 %d, out %d, ws %zu)\n", n_in, n_in > 0 ? in_sizes[0] : -1, out_size, ws_size); grid = -1; return; }
        int dev = 0, cus = 0;
        if (hipGetDevice(&dev) != hipSuccess || hipDeviceGetAttribute(&cus, hipDeviceAttributeMultiprocessorCount, dev) != hipSuccess) { grid = -1; return; }
        if (hipFuncSetAttribute((const void*)fwd, hipFuncAttributeMaxDynamicSharedMemorySize, LDS_BYTES) != hipSuccess) { fprintf(stderr, "kernel_launch: hipFuncSetAttribute failed\n"); grid = -1; return; }
        grid = cus;
    }
    if (grid < 0) return;
    Args a{};
    for (int i = 0; i < 22; ++i) a.in[i] = (const float*)d_in[i];
    a.out = (float*)d_out; a.ws = (unsigned char*)d_ws;
    for (int p = 0; p < NPHASE; ++p) {
        if (p == 6) continue;
        a.ph_lo = p; a.ph_hi = p + 1;
        hipLaunchKernelGGL(fwd, dim3(grid), dim3(NTHR), LDS_BYTES, stream, a);
    }
}
```

```cpp
#include <hip/hip_runtime.h>
#include <cstdio>
#include <cstdint>

#define GAS __attribute__((address_space(1)))
#define LAS __attribute__((address_space(3)))
typedef unsigned short bf16;
typedef unsigned v4u __attribute__((ext_vector_type(4)));
typedef unsigned v2u __attribute__((ext_vector_type(2)));
typedef float f32x4 __attribute__((ext_vector_type(4)));

constexpr int BATCH = 4, SEQ = 4096, D = 1024, M = BATCH * SEQ, DFF = 2816, NGU = 2 * DFF, INC = 3584;
constexpr int HF = 512, NH = 4, DK = 128, DV = 128, CHUNK = 64, NCHUNK = SEQ / CHUNK;
constexpr int MEML = 256, MH = 4, MHD = 256, MROWS = BATCH * MEML;
constexpr float EPS = 1e-6f;
constexpr int NWAVES = 8, NTHR = NWAVES * 64;
constexpr int NPHASE = 17;

constexpr size_t MiB = 1u << 20;
constexpr size_t WS_CTL = 0, CTL_ZERO_BYTES = 1 * MiB;
constexpr size_t WS_LB = 1 * MiB, WS_RS = 1 * MiB + 65536;
constexpr size_t WS_WGU1 = 2 * MiB, WS_WD1 = 13 * MiB, WS_WIN = WS_WD1 + 5 * MiB + 512 * 1024, WS_WOUT = WS_WIN + 7 * MiB, WS_WQ = WS_WOUT + 2 * MiB,
                 WS_WKV = WS_WQ + 2 * MiB, WS_WO = WS_WKV + 4 * MiB, WS_WGU2 = WS_WO + 2 * MiB, WS_WD2 = WS_WGU2 + 11 * MiB, WS_MN = 52 * MiB, WS_KM = 54 * MiB, WS_VMT = 56 * MiB,
                 WS_DEC = 58 * MiB;
static_assert(WS_WD2 + 5 * MiB + 512 * 1024 == WS_MN, "weight map");
constexpr size_t WS_XN = 64 * MiB, WS_HID = 96 * MiB, WS_XB = 216 * MiB;
constexpr size_t WS_Q = 64 * MiB, WS_KK = 80 * MiB, WS_LOGF = 96 * MiB, WS_V = 128 * MiB, WS_SG = 144 * MiB, WS_ZB = 160 * MiB, WS_P = 176 * MiB, WS_DS = 192 * MiB, WS_Y = 224 * MiB;
constexpr size_t WS_XB2 = 64 * MiB, WS_QM = 96 * MiB, WS_ATT = 128 * MiB, WS_END = 256 * MiB;

constexpr int RING_BYTES = 131072, LDSCTL_OFF = RING_BYTES, MISC_OFF = LDSCTL_OFF + 320, LDS_BYTES = 147456;

__device__ __forceinline__ unsigned f2bf(float f) { unsigned u = __builtin_bit_cast(unsigned, f); return (u + 0x7fffu + ((u >> 16) & 1u)) >> 16; }
__device__ __forceinline__ unsigned pk2(float lo, float hi) { return f2bf(lo) | (f2bf(hi) << 16); }
__device__ __forceinline__ float bflo(unsigned w) { return __builtin_bit_cast(float, w << 16); }
__device__ __forceinline__ float bfhi(unsigned w) { return __builtin_bit_cast(float, w & 0xffff0000u); }
__device__ __forceinline__ float bf2f(bf16 b) { return __builtin_bit_cast(float, (unsigned)b << 16); }
__device__ __forceinline__ float wave_sum(float v) {
#pragma unroll
    for (int o = 1; o < 64; o <<= 1) v += __shfl_xor(v, o);
    return v;
}
__device__ __forceinline__ float wave_max(float v) {
#pragma unroll
    for (int o = 1; o < 64; o <<= 1) v = fmaxf(v, __shfl_xor(v, o));
    return v;
}
__device__ __forceinline__ float silu_f(float x) { return x / (1.f + __expf(-x)); }
__device__ __forceinline__ float sigm_f(float x) { return 1.f / (1.f + __expf(-x)); }
__device__ __forceinline__ void unpack8(v4u w, float (&f)[8]) {
    f[0] = bflo(w.x); f[1] = bfhi(w.x); f[2] = bflo(w.y); f[3] = bfhi(w.y); f[4] = bflo(w.z); f[5] = bfhi(w.z); f[6] = bflo(w.w); f[7] = bfhi(w.w);
}
__device__ __forceinline__ v4u pack8(const float (&f)[8]) { v4u w; w.x = pk2(f[0], f[1]); w.y = pk2(f[2], f[3]); w.z = pk2(f[4], f[5]); w.w = pk2(f[6], f[7]); return w; }


typedef GAS unsigned gu32;
constexpr int CW_TMO = 0, CW_CODE = 1, CW_BAR = 4096;
#define XB_TMO      128
#define XB_XCNT(j)  (256  + 64 * (j))
#define XB_XSUB(j)  (1280 + 64 * (j))
#define XB_XGEN(j)  (2304 + 64 * (j))
#define XB_TOP      3328
#define XB_TOPGEN   3392
#define XCD_BAR_WORDS 3456
#define XB_SPIN_CAP (1u << 18)
__device__ __forceinline__ unsigned xb_ld(unsigned* p)              { return __hip_atomic_load(p, __ATOMIC_RELAXED, __HIP_MEMORY_SCOPE_AGENT); }
__device__ __forceinline__ unsigned xb_add(unsigned* p, unsigned v) { return __hip_atomic_fetch_add(p, v, __ATOMIC_RELAXED, __HIP_MEMORY_SCOPE_AGENT); }
__device__ __forceinline__ unsigned xb_xcc_id() { return (unsigned)__builtin_amdgcn_s_getreg((3 << 11) | 20) & 0xFu; }
#define XB_SPIN(cond, bar) do { unsigned _sp = 0; while (cond) { __builtin_amdgcn_s_sleep(1); \
    if ((++_sp & 255u) == 0u) { if (xb_ld(&(bar)[XB_TMO])) break; if (_sp > XB_SPIN_CAP) { atomicAdd(&(bar)[XB_TMO], 1u); break; } } } } while (0)
struct XcdBarrier { unsigned* bar; unsigned x; volatile LAS unsigned* st; };
__device__ __forceinline__ XcdBarrier xcd_barrier_post(unsigned* bar, volatile LAS unsigned* st) {
    XcdBarrier b; b.bar = bar; b.x = xb_xcc_id(); b.st = st;
    if (threadIdx.x == 0) (void)xb_add(&bar[XB_XCNT(b.x)], 1u);
    return b;
}
__device__ __forceinline__ void xcd_barrier_complete(unsigned* bar, unsigned x, unsigned& nloc, unsigned& nx) {
    const unsigned G = gridDim.x * gridDim.y * gridDim.z;
    unsigned sum, cnt, mine, sp = 0u;
    for (;;) {
        sum = 0u; cnt = 0u; mine = 0u;
#pragma unroll
        for (unsigned j = 0; j < 16; ++j) { const unsigned c = xb_ld(&bar[XB_XCNT(j)]); sum += c; cnt += (c > 0u) ? 1u : 0u; mine = (j == x) ? c : mine; }
        if (sum == G) break;
        __builtin_amdgcn_s_sleep(1);
        if ((++sp & 255u) == 0u) { if (xb_ld(&bar[XB_TMO])) break; if (sp > XB_SPIN_CAP) { atomicAdd(&bar[XB_TMO], 1u); break; } }
    }
    nloc = mine > 0u ? mine : 1u; nx = cnt > 0u ? cnt : 1u;
}
__device__ __forceinline__ void xcd_barrier(const XcdBarrier& b) {
    asm volatile("s_waitcnt vmcnt(0)" ::: "memory");
    __syncthreads();
    if (threadIdx.x == 0) {
        unsigned* bar = b.bar;
        __builtin_amdgcn_s_waitcnt(0);
        unsigned nloc = b.st[0], nx = b.st[1];
        if (nloc == 0u) { xcd_barrier_complete(bar, b.x, nloc, nx); b.st[0] = nloc; b.st[1] = nx; }
        const unsigned old = xb_add(&bar[XB_XSUB(b.x)], 1u);
        const unsigned gen = old / nloc;
        if (old + 1u == (gen + 1u) * nloc) {
            __builtin_amdgcn_fence(__ATOMIC_RELEASE, "agent");
            asm volatile("s_waitcnt vmcnt(0)" ::: "memory");
            const unsigned og = xb_add(&bar[XB_TOP], 1u);
            const unsigned tg = og / nx;
            if (og + 1u == (tg + 1u) * nx) xb_add(&bar[XB_TOPGEN], 1u);
            else XB_SPIN(xb_ld(&bar[XB_TOPGEN]) == tg, bar);
            __builtin_amdgcn_fence(__ATOMIC_ACQUIRE, "agent");
            xb_add(&bar[XB_XGEN(b.x)], 1u);
            asm volatile("s_waitcnt vmcnt(0)" ::: "memory");
        } else {
            XB_SPIN(xb_ld(&bar[XB_XGEN(b.x)]) == gen, bar);
            __builtin_amdgcn_fence(__ATOMIC_ACQUIRE, "agent");
            asm volatile("s_waitcnt vmcnt(0)" ::: "memory");
        }
    }
    __syncthreads();
}

struct Frame {
    LAS unsigned char* lds;
    int tid, lane, wave, vcu, G;
    long gtid, NT;
    int gw, NGW;
    const float* const* in; float* out; unsigned char* ws;
};

struct EmGU {
    bf16* HID; const float* RS;
    __device__ __forceinline__ void operator()(int row, int pn, int c8, const float (&a)[8], const float (&b)[8]) const {
        const float r = RS ? RS[row] : 1.f; float h[8];
#pragma unroll
        for (int j = 0; j < 8; ++j) h[j] = silu_f(r * a[j]) * (r * b[j]);
        *(v4u*)(HID + (size_t)row * DFF + 128 * pn + c8) = pack8(h);
    }
};
struct EmRes {
    const float* XIN; float* XF; bf16* XB; float scale;
    __device__ __forceinline__ void operator()(int row, int pn, int c8, const float (&a)[8], const float (&b)[8]) const {
#pragma unroll
        for (int hh = 0; hh < 2; ++hh) {
            const size_t off = (size_t)row * D + 256 * pn + 128 * hh + c8;
            const f32x4 x0 = *(const f32x4*)(XIN + off), x1 = *(const f32x4*)(XIN + off + 4);
            float o[8];
#pragma unroll
            for (int j = 0; j < 4; ++j) { o[j] = x0[j] + scale * (hh ? b[j] : a[j]); o[4 + j] = x1[j] + scale * (hh ? b[4 + j] : a[4 + j]); }
            *(f32x4*)(XF + off) = (f32x4){o[0], o[1], o[2], o[3]}; *(f32x4*)(XF + off + 4) = (f32x4){o[4], o[5], o[6], o[7]};
            if (XB) *(v4u*)(XB + off) = pack8(o);
        }
    }
};
struct EmIn {
    bf16 *Q, *KK, *V, *SG, *ZB, *P; float* LOGF; const float* RS; const float* LB;
    __device__ __forceinline__ void operator()(int row, int pn, int c8, const float (&a)[8], const float (&b)[8]) const {
        const float r = RS[row];
        if (pn >= 10) {
            float o[8];
#pragma unroll
            for (int j = 0; j < 8; ++j) o[j] = (r * a[j]) * (r * b[j]);
            *(v4u*)(P + (size_t)row * 512 + 128 * (pn - 10) + c8) = pack8(o);
            return;
        }
        const int kind = pn >> 1;
#pragma unroll
        for (int hh = 0; hh < 2; ++hh) {
            const int col = 256 * (pn & 1) + 128 * hh + c8; const size_t off = (size_t)row * 512 + col;
            float z[8], o[8];
#pragma unroll
            for (int j = 0; j < 8; ++j) z[j] = r * (hh ? b[j] : a[j]);
            if (kind == 0) {
#pragma unroll
                for (int j = 0; j < 8; ++j) o[j] = silu_f(z[j]) * 0.08838834764831845f;
                *(v4u*)(Q + off) = pack8(o);
            } else if (kind == 1) {
                float lf[8];
                const f32x4 l0 = *(const f32x4*)(LB + col), l1 = *(const f32x4*)(LB + col + 4);
#pragma unroll
                for (int j = 0; j < 8; ++j) { const float lb = j < 4 ? l0[j] : l1[j - 4]; const float f = lb + (1.f - lb) * sigm_f(z[j]); o[j] = 1.f - f; lf[j] = __logf(f); }
                *(v4u*)(KK + off) = pack8(o);
                *(f32x4*)(LOGF + off) = (f32x4){lf[0], lf[1], lf[2], lf[3]}; *(f32x4*)(LOGF + off + 4) = (f32x4){lf[4], lf[5], lf[6], lf[7]};
            } else if (kind == 2) { *(v4u*)(V + off) = pack8(z);
            } else if (kind == 3) {
#pragma unroll
                for (int j = 0; j < 8; ++j) o[j] = silu_f(z[j]);
                *(v4u*)(SG + off) = pack8(o);
            } else { *(v4u*)(ZB + off) = pack8(z); }
        }
    }
};
struct EmPlain {
    bf16* O; const float* RS; float scale;
    __device__ __forceinline__ void operator()(int row, int pn, int c8, const float (&a)[8], const float (&b)[8]) const {
        const float r = (RS ? RS[row] : 1.f) * scale; float o[8];
#pragma unroll
        for (int j = 0; j < 8; ++j) o[j] = r * a[j];
        *(v4u*)(O + (size_t)row * 1024 + 256 * pn + c8) = pack8(o);
#pragma unroll
        for (int j = 0; j < 8; ++j) o[j] = r * b[j];
        *(v4u*)(O + (size_t)row * 1024 + 256 * pn + 128 + c8) = pack8(o);
    }
};

template <class Emit>
__device__ __forceinline__ void naive_gemm(const Frame& F, const bf16* A, const bf16* Bt, int Mr, int N, int K, const Emit& E) {
    const long nitem = (long)Mr * (N / 256) * 16;
    for (long i = F.gtid; i < nitem; i += F.NT) {
        const int l = (int)(i & 63); const long g = i >> 6; const int rg = (int)(g % (Mr / 4)), pn = (int)(g / (Mr / 4));
        const int row = rg * 4 + (l >> 4), c8 = (l & 15) * 8;
        float a[8], b[8];
#pragma unroll
        for (int j = 0; j < 8; ++j) { a[j] = 0.f; b[j] = 0.f; }
        const bf16* ap = A + (size_t)row * K; const bf16* bp = Bt + (size_t)(256 * pn + c8) * K;
        for (int k = 0; k < K; k += 8) {
            float av[8]; unpack8(*(const v4u*)(ap + k), av);
#pragma unroll
            for (int j = 0; j < 8; ++j) {
                float bv[8]; unpack8(*(const v4u*)(bp + (size_t)j * K + k), bv);
                float cv[8]; unpack8(*(const v4u*)(bp + (size_t)(128 + j) * K + k), cv);
#pragma unroll
                for (int e = 0; e < 8; ++e) { a[j] += av[e] * bv[e]; b[j] += av[e] * cv[e]; }
            }
        }
        E(row, pn, c8, a, b);
    }
}

__device__ __forceinline__ void transpose_item(const float* W, int ldw, int col0, const float* g, bf16* WT, int Kd, int n0, int k0, LAS float* scr, int lane) {
#pragma unroll 8
    for (int i = 0; i < 32; ++i) { const int kk = 2 * i + (lane >> 5); const float gv = g ? g[k0 + kk] : 1.f; scr[kk * 33 + (lane & 31)] = W[(size_t)(k0 + kk) * ldw + col0 + (lane & 31)] * gv; }
    asm volatile("s_waitcnt lgkmcnt(0)" ::: "memory");
    const int c = lane & 7;
#pragma unroll
    for (int j = 0; j < 4; ++j) { const int n = (lane >> 3) + 8 * j; const LAS float* s = scr + (8 * c) * 33 + n;
        v4u o; o.x = pk2(s[0 * 33], s[1 * 33]); o.y = pk2(s[2 * 33], s[3 * 33]); o.z = pk2(s[4 * 33], s[5 * 33]); o.w = pk2(s[6 * 33], s[7 * 33]);
        *(v4u*)(WT + (size_t)(n0 + n) * Kd + k0 + 8 * c) = o; }
    asm volatile("s_waitcnt lgkmcnt(0)" ::: "memory");
}
__device__ __forceinline__ void norm_row_bf16(const float* xrow, const float* gain, bf16* orow, int lane) {
    const f32x4* xr = (const f32x4*)xrow + lane; f32x4 v[4]; float s = 0.f;
#pragma unroll
    for (int j = 0; j < 4; ++j) { v[j] = xr[64 * j]; s += (v[j].x * v[j].x + v[j].y * v[j].y) + (v[j].z * v[j].z + v[j].w * v[j].w); }
    const float r = 1.f / sqrtf(wave_sum(s) * (1.f / D) + EPS);
    v2u* o8 = (v2u*)orow + lane;
#pragma unroll
    for (int j = 0; j < 4; ++j) { f32x4 gg = gain ? ((const f32x4*)gain)[lane + 64 * j] : (f32x4){1.f, 1.f, 1.f, 1.f};
        v2u w; w.x = pk2(v[j].x * r * gg.x, v[j].y * r * gg.y); w.y = pk2(v[j].z * r * gg.z, v[j].w * r * gg.w); o8[64 * j] = w; }
}
__device__ __forceinline__ void p_prologue(const Frame& F) {
    LAS float* scr = (LAS float*)(F.lds + F.wave * 16384);
    unsigned char* ws = F.ws;
    constexpr int I_GU = 16 * (NGU / 32), I_D = (DFF / 64) * (D / 32), I_IN = 16 * (INC / 32), I_SQ = 16 * 32, I_KV = 16 * 64;
    constexpr int NITEMS = 2 * I_GU + 2 * I_D + I_IN + 3 * I_SQ + I_KV;
    for (int it = F.gw; it < NITEMS; it += F.NGW) {
        int r = it;
        if (r < 2 * I_GU) {
            const int which = r / I_GU; r -= which * I_GU; const int nb = r % (NGU / 32), kb = r / (NGU / 32), n0 = 32 * nb, t = n0 / 256, w = n0 % 256, half = w / 128, col = 128 * t + (w % 128);
            const float* W = F.in[(which ? 18 : 3) + half]; const float* g = F.in[which ? 17 : 2];
            transpose_item(W, DFF, col, g, (bf16*)(ws + (which ? WS_WGU2 : WS_WGU1)), D, n0, 64 * kb, scr, F.lane); continue; }
        r -= 2 * I_GU;
        if (r < 2 * I_D) { const int which = r / I_D; r -= which * I_D; const int nb = r % (D / 32), kb = r / (D / 32);
            transpose_item(F.in[which ? 20 : 5], D, 32 * nb, nullptr, (bf16*)(ws + (which ? WS_WD2 : WS_WD1)), DFF, 32 * nb, 64 * kb, scr, F.lane); continue; }
        r -= 2 * I_D;
        if (r < I_IN) { const int nb = r % (INC / 32), kb = r / (INC / 32), n0 = 32 * nb; int col = n0;
            if (n0 >= 2560) { const int t = (n0 - 2560) / 256, w = (n0 - 2560) % 256, half = w / 128; col = (half ? 3072 : 2560) + 128 * t + (w % 128); }
            transpose_item(F.in[7], INC, col, F.in[6], (bf16*)(ws + WS_WIN), D, n0, 64 * kb, scr, F.lane); continue; }
        r -= I_IN;
        if (r < 3 * I_SQ) { const int which = r / I_SQ; r -= which * I_SQ; const int nb = r % 32, kb = r / 32;
            const float* W = F.in[which == 0 ? 11 : (which == 1 ? 14 : 16)]; const float* g = which == 1 ? F.in[12] : nullptr;
            bf16* dst = (bf16*)(ws + (which == 0 ? WS_WOUT : (which == 1 ? WS_WQ : WS_WO)));
            transpose_item(W, D, 32 * nb, g, dst, D, 32 * nb, 64 * kb, scr, F.lane); continue; }
        r -= 3 * I_SQ;
        { const int nb = r % 64, kb = r / 64; transpose_item(F.in[15], 2 * D, 32 * nb, nullptr, (bf16*)(ws + WS_WKV), D, 32 * nb, 64 * kb, scr, F.lane); }
    }
    for (int m = F.gw; m < M; m += F.NGW) norm_row_bf16(F.in[0] + (size_t)m * D, nullptr, (bf16*)(ws + WS_XN) + (size_t)m * D, F.lane);
    for (int m = F.gw; m < MROWS; m += F.NGW) norm_row_bf16(F.in[1] + (size_t)m * D, F.in[13], (bf16*)(ws + WS_MN) + (size_t)m * D, F.lane);
    if (F.gtid < HF) { const float p0 = F.in[8][F.gtid], p1 = F.in[8][HF + F.gtid]; const float mx = fmaxf(p0, p1), e0 = __expf(p0 - mx), e1 = __expf(p1 - mx);
        ((float*)(ws + WS_LB))[F.gtid] = e0 / (e0 + e1); }
}

__device__ __forceinline__ void p_rowstat(const Frame& F) {
    float* RS = (float*)(F.ws + WS_RS);
    for (int m = F.gw; m < M; m += F.NGW) {
        const f32x4* xr = (const f32x4*)(F.out + (size_t)m * D) + F.lane; float s = 0.f;
#pragma unroll
        for (int j = 0; j < 4; ++j) { const f32x4 v = xr[64 * j]; s += (v.x * v.x + v.y * v.y) + (v.z * v.z + v.w * v.w); }
        s = wave_sum(s);
        if (F.lane == 0) RS[m] = 1.f / sqrtf(s * (1.f / D) + EPS);
    }
}
__device__ __forceinline__ void p_final(const Frame& F) {
    const float* g = F.in[21];
    for (int m = F.gw; m < M; m += F.NGW) {
        f32x4* xr = (f32x4*)(F.out + (size_t)m * D) + F.lane; f32x4 v[4]; float s = 0.f;
#pragma unroll
        for (int j = 0; j < 4; ++j) { v[j] = xr[64 * j]; s += (v[j].x * v[j].x + v[j].y * v[j].y) + (v[j].z * v[j].z + v[j].w * v[j].w); }
        const float r = 1.f / sqrtf(wave_sum(s) * (1.f / D) + EPS);
#pragma unroll
        for (int j = 0; j < 4; ++j) { const f32x4 gg = ((const f32x4*)g)[F.lane + 64 * j]; xr[64 * j] = (f32x4){v[j].x * r * gg.x, v[j].y * r * gg.y, v[j].z * r * gg.z, v[j].w * r * gg.w}; }
    }
}

__device__ __forceinline__ void p_conv(const Frame& F) {
    const bf16* ZB = (const bf16*)(F.ws + WS_ZB); const bf16* P = (const bf16*)(F.ws + WS_P); bf16* Y = (bf16*)(F.ws + WS_Y); const float* cw = F.in[10];
    const long nitem = (long)M * 64;
    for (long i = F.gtid; i < nitem; i += F.NT) {
        const int row = (int)(i >> 6), c8 = (int)(i & 63) * 8, t = row % SEQ;
        float zb[8], p0[8], p1[8], p2[8], o[8];
        unpack8(*(const v4u*)(ZB + (size_t)row * 512 + c8), zb);
        unpack8(*(const v4u*)(P + (size_t)row * 512 + c8), p2);
        if (t >= 1) unpack8(*(const v4u*)(P + (size_t)(row - 1) * 512 + c8), p1); else {
#pragma unroll
            for (int j = 0; j < 8; ++j) p1[j] = 0.f; }
        if (t >= 2) unpack8(*(const v4u*)(P + (size_t)(row - 2) * 512 + c8), p0); else {
#pragma unroll
            for (int j = 0; j < 8; ++j) p0[j] = 0.f; }
#pragma unroll
        for (int j = 0; j < 8; ++j) { const float* w = cw + (c8 + j) * 3; o[j] = zb[j] * (w[0] * p0[j] + w[1] * p1[j] + w[2] * p2[j]); }
        *(v4u*)(Y + (size_t)row * D + 512 + c8) = pack8(o);
    }
}

__device__ __forceinline__ void p_scan_simple(const Frame& F) {
    const bf16* Q = (const bf16*)(F.ws + WS_Q); const bf16* KK = (const bf16*)(F.ws + WS_KK); const bf16* V = (const bf16*)(F.ws + WS_V); const float* LOGF = (const float*)(F.ws + WS_LOGF);
    float* O32 = (float*)(F.ws + WS_DS);
    if (F.gtid < BATCH * NH * DV) {
    const int dv = (int)(F.gtid % DV), h = (int)(F.gtid / DV) % NH, b = (int)(F.gtid / (DV * NH));
    float S[DK];
#pragma unroll
    for (int i = 0; i < DK; ++i) S[i] = 0.f;
    for (int t = 0; t < SEQ; ++t) {
        const size_t rb = ((size_t)b * SEQ + t) * 512 + h * 128;
        const float v = bf2f(V[rb + dv]); float o = 0.f;
#pragma unroll
        for (int i8 = 0; i8 < DK / 8; ++i8) {
            float q[8], k[8]; unpack8(*(const v4u*)(Q + rb + 8 * i8), q); unpack8(*(const v4u*)(KK + rb + 8 * i8), k);
            const f32x4 l0 = *(const f32x4*)(LOGF + rb + 8 * i8), l1 = *(const f32x4*)(LOGF + rb + 8 * i8 + 4);
#pragma unroll
            for (int j = 0; j < 8; ++j) { const float f = __expf(j < 4 ? l0[j] : l1[j - 4]); S[8 * i8 + j] = f * S[8 * i8 + j] + k[j] * v; o += S[8 * i8 + j] * q[j]; }
        }
        O32[((size_t)b * SEQ + t) * 512 + h * 128 + dv] = o;
    }
    }
}
__device__ __forceinline__ void p_hnorm_simple(const Frame& F) {
    const float* O32 = (const float*)(F.ws + WS_DS); const bf16* SG = (const bf16*)(F.ws + WS_SG); bf16* Y = (bf16*)(F.ws + WS_Y); const float* g = F.in[9];
    for (int it = F.gw; it < M * NH; it += F.NGW) {
        const int row = it >> 2, h = it & 3; const size_t off = (size_t)row * 512 + h * 128 + 2 * F.lane;
        const float o0 = O32[off], o1 = O32[off + 1];
        const float r = 1.f / sqrtf(wave_sum(o0 * o0 + o1 * o1) * (1.f / DV) + EPS);
        const unsigned sg = *(const unsigned*)(SG + off);
        *(unsigned*)(Y + (size_t)row * D + h * 128 + 2 * F.lane) = pk2(o0 * r * g[h * 128 + 2 * F.lane] * bflo(sg), o1 * r * g[h * 128 + 2 * F.lane + 1] * bfhi(sg));
    }
}

__device__ __forceinline__ void p_attn_simple(const Frame& F) {
    const bf16* QM = (const bf16*)(F.ws + WS_QM); const bf16* KM = (const bf16*)(F.ws + WS_KM); const bf16* VMT = (const bf16*)(F.ws + WS_VMT); bf16* ATT = (bf16*)(F.ws + WS_ATT);
    const int lane = F.lane;
    for (int it = F.gw; it < M * MH; it += F.NGW) {
        const int row = it >> 2, h = it & 3, b = row / SEQ;
        const v2u qw = *(const v2u*)(QM + (size_t)row * D + h * MHD + 4 * lane);
        const float q0 = bflo(qw.x), q1 = bfhi(qw.x), q2 = bflo(qw.y), q3 = bfhi(qw.y);
        float sc[4];
#pragma unroll
        for (int jj = 0; jj < 4; ++jj) {
            float mine = 0.f;
            for (int jl = 0; jl < 64; ++jl) {
                const v2u kw = *(const v2u*)(KM + (size_t)(b * MEML + jj * 64 + jl) * D + h * MHD + 4 * lane);
                const float s = wave_sum(q0 * bflo(kw.x) + q1 * bfhi(kw.x) + q2 * bflo(kw.y) + q3 * bfhi(kw.y));
                if (lane == jl) mine = s;
            }
            sc[jj] = mine;
        }
        const float mx = wave_max(fmaxf(fmaxf(sc[0], sc[1]), fmaxf(sc[2], sc[3])));
        float l = 0.f;
#pragma unroll
        for (int jj = 0; jj < 4; ++jj) { sc[jj] = __expf(sc[jj] - mx); l += sc[jj]; }
        const float inv = 1.f / wave_sum(l);
        float acc[4] = {0.f, 0.f, 0.f, 0.f};
#pragma unroll
        for (int jj = 0; jj < 4; ++jj)
            for (int jc = 0; jc < 8; ++jc) {
                float p[8];
#pragma unroll
                for (int e = 0; e < 8; ++e) p[e] = __shfl(sc[jj], jc * 8 + e);
#pragma unroll
                for (int i = 0; i < 4; ++i) { float vv[8]; unpack8(*(const v4u*)(VMT + (size_t)(h * MHD + 4 * lane + i) * MROWS + b * MEML + jj * 64 + jc * 8), vv);
#pragma unroll
                    for (int e = 0; e < 8; ++e) acc[i] += p[e] * vv[e]; }
            }
        v2u o; o.x = pk2(acc[0] * inv, acc[1] * inv); o.y = pk2(acc[2] * inv, acc[3] * inv);
        *(v2u*)(ATT + (size_t)row * D + h * MHD + 4 * lane) = o;
    }
}

struct Args { const float* in[22]; float* out; unsigned char* ws; int ph_lo, ph_hi; };
__global__ void __launch_bounds__(NTHR, 2) fwd(Args args) {
    extern __shared__ __attribute__((aligned(16))) unsigned char lds[];
    Frame F;
    F.lds = (LAS unsigned char*)lds;
    F.tid = threadIdx.x; F.lane = F.tid & 63; F.wave = __builtin_amdgcn_readfirstlane(F.tid >> 6);
    F.G = gridDim.x; { const int bx = blockIdx.x; F.vcu = (F.G % 8 == 0) ? (bx % 8) * (F.G / 8) + bx / 8 : bx; }
    F.gtid = (long)F.vcu * NTHR + F.tid; F.NT = (long)F.G * NTHR; F.gw = F.vcu * NWAVES + F.wave; F.NGW = F.G * NWAVES;
    F.in = args.in;
    F.out = args.out; F.ws = args.ws;
    unsigned char* ws = args.ws;
    const int lo = args.ph_lo, hi = args.ph_hi;
    for (int u = F.tid; u < (LDS_BYTES - LDSCTL_OFF) / 4; u += NTHR) ((LAS unsigned*)(F.lds + LDSCTL_OFF))[u] = 0u;
    __syncthreads();
    XcdBarrier bar; bar.bar = (unsigned*)(ws + WS_CTL) + CW_BAR; bar.x = 0; bar.st = nullptr;
    if (hi - lo > 1) bar = xcd_barrier_post((unsigned*)(ws + WS_CTL) + CW_BAR, (volatile LAS unsigned*)(F.lds + MISC_OFF) + 8);
#define IN(k) (lo <= (k) && (k) < hi)
#define SEAM(k) do { if (IN(k) && IN((k) + 1)) xcd_barrier(bar); } while (0)
    const float* RS = (const float*)(ws + WS_RS);
    if (IN(0)) p_prologue(F);
    SEAM(0);
    if (IN(1)) {
        naive_gemm(F, (const bf16*)(ws + WS_XN), (const bf16*)(ws + WS_WGU1), M, NGU, D, EmGU{(bf16*)(ws + WS_HID), nullptr});
        naive_gemm(F, (const bf16*)(ws + WS_MN), (const bf16*)(ws + WS_WKV), MROWS, D, D, EmPlain{(bf16*)(ws + WS_KM), nullptr, 1.f});
        naive_gemm(F, (const bf16*)(ws + WS_WKV) + (size_t)D * D, (const bf16*)(ws + WS_MN), D, MROWS, D, EmPlain{(bf16*)(ws + WS_VMT), nullptr, 1.f});
    }
    SEAM(1);
    if (IN(2)) naive_gemm(F, (const bf16*)(ws + WS_HID), (const bf16*)(ws + WS_WD1), M, D, DFF, EmRes{F.in[0], F.out, (bf16*)(ws + WS_XB), 0.5f});
    SEAM(2);
    if (IN(3)) p_rowstat(F);
    SEAM(3);
    if (IN(4)) naive_gemm(F, (const bf16*)(ws + WS_XB), (const bf16*)(ws + WS_WIN), M, INC, D,
                          EmIn{(bf16*)(ws + WS_Q), (bf16*)(ws + WS_KK), (bf16*)(ws + WS_V), (bf16*)(ws + WS_SG), (bf16*)(ws + WS_ZB), (bf16*)(ws + WS_P), (float*)(ws + WS_LOGF), RS, (const float*)(ws + WS_LB)});
    SEAM(4);
    if (IN(5)) { p_conv(F); p_scan_simple(F); }
    SEAM(5);
    if (IN(6)) {}
    SEAM(6);
    if (IN(7)) p_hnorm_simple(F);
    SEAM(7);
    if (IN(8)) naive_gemm(F, (const bf16*)(ws + WS_Y), (const bf16*)(ws + WS_WOUT), M, D, D, EmRes{F.out, F.out, (bf16*)(ws + WS_XB2), 1.f});
    SEAM(8);
    if (IN(9)) p_rowstat(F);
    SEAM(9);
    if (IN(10)) naive_gemm(F, (const bf16*)(ws + WS_XB2), (const bf16*)(ws + WS_WQ), M, D, D, EmPlain{(bf16*)(ws + WS_QM), RS, 0.0625f});
    SEAM(10);
    if (IN(11)) p_attn_simple(F);
    SEAM(11);
    if (IN(12)) naive_gemm(F, (const bf16*)(ws + WS_ATT), (const bf16*)(ws + WS_WO), M, D, D, EmRes{F.out, F.out, (bf16*)(ws + WS_XB2), 1.f});
    SEAM(12);
    if (IN(13)) p_rowstat(F);
    SEAM(13);
    if (IN(14)) naive_gemm(F, (const bf16*)(ws + WS_XB2), (const bf16*)(ws + WS_WGU2), M, NGU, D, EmGU{(bf16*)(ws + WS_HID), RS});
    SEAM(14);
    if (IN(15)) naive_gemm(F, (const bf16*)(ws + WS_HID), (const bf16*)(ws + WS_WD2), M, D, DFF, EmRes{F.out, F.out, nullptr, 0.5f});
    SEAM(15);
    if (IN(16)) p_final(F);
#undef IN
#undef SEAM
}

extern "C" void kernel_launch(void* const* d_in, const int* in_sizes, int n_in, void* d_out, int out_size, void* d_ws, size_t ws_size, hipStream_t stream) {
    static int grid = 0;
    if (grid == 0) {
        if (n_in != 22 || in_sizes[0] != M * D || out_size != M * D || ws_size < WS_END) { fprintf(stderr, "kernel_launch: unexpected shapes (n_in %d, in0 %d, out %d, ws %zu)\n", n_in, n_in > 0 ? in_sizes[0] : -1, out_size, ws_size); grid = -1; return; }
        int dev = 0, cus = 0;
        if (hipGetDevice(&dev) != hipSuccess || hipDeviceGetAttribute(&cus, hipDeviceAttributeMultiprocessorCount, dev) != hipSuccess) { grid = -1; return; }
        if (hipFuncSetAttribute((const void*)fwd, hipFuncAttributeMaxDynamicSharedMemorySize, LDS_BYTES) != hipSuccess) { fprintf(stderr, "kernel_launch: hipFuncSetAttribute failed\n"); grid = -1; return; }
        grid = cus;
    }
    if (grid < 0) return;
    Args a{};
    for (int i = 0; i < 22; ++i) a.in[i] = (const float*)d_in[i];
    a.out = (float*)d_out; a.ws = (unsigned char*)d_ws;
    if (hipMemsetAsync((char*)d_ws + WS_CTL, 0, CTL_ZERO_BYTES, stream) != hipSuccess) { fprintf(stderr, "kernel_launch: memset failed\n"); return; }
    a.ph_lo = 0; a.ph_hi = NPHASE;
    void* kargs[] = {&a};
    hipError_t e = hipLaunchCooperativeKernel((const void*)fwd, dim3(grid), dim3(NTHR), kargs, LDS_BYTES, stream);
    if (e != hipSuccess) fprintf(stderr, "kernel_launch: cooperative launch failed: %s (grid %d)\n", hipGetErrorString(e), grid);
}
```

```cpp
#include <hip/hip_runtime.h>
#include <cstdio>
#include <cstdint>

#define GAS __attribute__((address_space(1)))
#define LAS __attribute__((address_space(3)))
typedef unsigned short bf16;
typedef unsigned v4u __attribute__((ext_vector_type(4)));
typedef unsigned v2u __attribute__((ext_vector_type(2)));
typedef float f32x4 __attribute__((ext_vector_type(4)));

constexpr int BATCH = 4, SEQ = 4096, D = 1024, M = BATCH * SEQ, DFF = 2816, NGU = 2 * DFF, INC = 3584;
constexpr int HF = 512, NH = 4, DK = 128, DV = 128, CHUNK = 64, NCHUNK = SEQ / CHUNK;
constexpr int MEML = 256, MH = 4, MHD = 256, MROWS = BATCH * MEML;
constexpr float EPS = 1e-6f;
constexpr int NWAVES = 8, NTHR = NWAVES * 64;
constexpr int NPHASE = 17;

constexpr size_t MiB = 1u << 20;
constexpr size_t WS_CTL = 0, CTL_ZERO_BYTES = 1 * MiB;
constexpr size_t WS_LB = 1 * MiB, WS_RS = 1 * MiB + 65536;
constexpr size_t WS_WGU1 = 2 * MiB, WS_WD1 = 13 * MiB, WS_WIN = WS_WD1 + 5 * MiB + 512 * 1024, WS_WOUT = WS_WIN + 7 * MiB, WS_WQ = WS_WOUT + 2 * MiB,
                 WS_WKV = WS_WQ + 2 * MiB, WS_WO = WS_WKV + 4 * MiB, WS_WGU2 = WS_WO + 2 * MiB, WS_WD2 = WS_WGU2 + 11 * MiB, WS_MN = 52 * MiB, WS_KM = 54 * MiB, WS_VMT = 56 * MiB,
                 WS_DEC = 58 * MiB;
static_assert(WS_WD2 + 5 * MiB + 512 * 1024 == WS_MN, "weight map");
constexpr size_t WS_XN = 64 * MiB, WS_HID = 96 * MiB, WS_XB = 216 * MiB;
constexpr size_t WS_Q = 64 * MiB, WS_KK = 80 * MiB, WS_LOGF = 96 * MiB, WS_V = 128 * MiB, WS_SG = 144 * MiB, WS_ZB = 160 * MiB, WS_P = 176 * MiB, WS_DS = 192 * MiB, WS_Y = 224 * MiB;
constexpr size_t WS_XB2 = 64 * MiB, WS_QM = 96 * MiB, WS_ATT = 128 * MiB, WS_END = 256 * MiB;

constexpr int RING_BYTES = 131072, LDSCTL_OFF = RING_BYTES, MISC_OFF = LDSCTL_OFF + 320, LDS_BYTES = 147456;

__device__ __forceinline__ unsigned f2bf(float f) { unsigned u = __builtin_bit_cast(unsigned, f); return (u + 0x7fffu + ((u >> 16) & 1u)) >> 16; }
__device__ __forceinline__ unsigned pk2(float lo, float hi) { return f2bf(lo) | (f2bf(hi) << 16); }
__device__ __forceinline__ float bflo(unsigned w) { return __builtin_bit_cast(float, w << 16); }
__device__ __forceinline__ float bfhi(unsigned w) { return __builtin_bit_cast(float, w & 0xffff0000u); }
__device__ __forceinline__ float bf2f(bf16 b) { return __builtin_bit_cast(float, (unsigned)b << 16); }
__device__ __forceinline__ float wave_sum(float v) {
#pragma unroll
    for (int o = 1; o < 64; o <<= 1) v += __shfl_xor(v, o);
    return v;
}
__device__ __forceinline__ float wave_max(float v) {
#pragma unroll
    for (int o = 1; o < 64; o <<= 1) v = fmaxf(v, __shfl_xor(v, o));
    return v;
}
__device__ __forceinline__ float silu_f(float x) { return x / (1.f + __expf(-x)); }
__device__ __forceinline__ float sigm_f(float x) { return 1.f / (1.f + __expf(-x)); }
__device__ __forceinline__ void unpack8(v4u w, float (&f)[8]) {
    f[0] = bflo(w.x); f[1] = bfhi(w.x); f[2] = bflo(w.y); f[3] = bfhi(w.y); f[4] = bflo(w.z); f[5] = bfhi(w.z); f[6] = bflo(w.w); f[7] = bfhi(w.w);
}
__device__ __forceinline__ v4u pack8(const float (&f)[8]) { v4u w; w.x = pk2(f[0], f[1]); w.y = pk2(f[2], f[3]); w.z = pk2(f[4], f[5]); w.w = pk2(f[6], f[7]); return w; }


typedef GAS unsigned gu32;
constexpr int CW_TMO = 0, CW_CODE = 1, CW_BAR = 4096;
#define XB_TMO      128
#define XB_XCNT(j)  (256  + 64 * (j))
#define XB_XSUB(j)  (1280 + 64 * (j))
#define XB_XGEN(j)  (2304 + 64 * (j))
#define XB_TOP      3328
#define XB_TOPGEN   3392
#define XCD_BAR_WORDS 3456
#define XB_SPIN_CAP (1u << 18)
__device__ __forceinline__ unsigned xb_ld(unsigned* p)              { return __hip_atomic_load(p, __ATOMIC_RELAXED, __HIP_MEMORY_SCOPE_AGENT); }
__device__ __forceinline__ unsigned xb_add(unsigned* p, unsigned v) { return __hip_atomic_fetch_add(p, v, __ATOMIC_RELAXED, __HIP_MEMORY_SCOPE_AGENT); }
__device__ __forceinline__ unsigned xb_xcc_id() { return (unsigned)__builtin_amdgcn_s_getreg((3 << 11) | 20) & 0xFu; }
#define XB_SPIN(cond, bar) do { unsigned _sp = 0; while (cond) { __builtin_amdgcn_s_sleep(1); \
    if ((++_sp & 255u) == 0u) { if (xb_ld(&(bar)[XB_TMO])) break; if (_sp > XB_SPIN_CAP) { atomicAdd(&(bar)[XB_TMO], 1u); break; } } } } while (0)
struct XcdBarrier { unsigned* bar; unsigned x; volatile LAS unsigned* st; };
__device__ __forceinline__ XcdBarrier xcd_barrier_post(unsigned* bar, volatile LAS unsigned* st) {
    XcdBarrier b; b.bar = bar; b.x = xb_xcc_id(); b.st = st;
    if (threadIdx.x == 0) (void)xb_add(&bar[XB_XCNT(b.x)], 1u);
    return b;
}
__device__ __forceinline__ void xcd_barrier_complete(unsigned* bar, unsigned x, unsigned& nloc, unsigned& nx) {
    const unsigned G = gridDim.x * gridDim.y * gridDim.z;
    unsigned sum, cnt, mine, sp = 0u;
    for (;;) {
        sum = 0u; cnt = 0u; mine = 0u;
#pragma unroll
        for (unsigned j = 0; j < 16; ++j) { const unsigned c = xb_ld(&bar[XB_XCNT(j)]); sum += c; cnt += (c > 0u) ? 1u : 0u; mine = (j == x) ? c : mine; }
        if (sum == G) break;
        __builtin_amdgcn_s_sleep(1);
        if ((++sp & 255u) == 0u) { if (xb_ld(&bar[XB_TMO])) break; if (sp > XB_SPIN_CAP) { atomicAdd(&bar[XB_TMO], 1u); break; } }
    }
    nloc = mine > 0u ? mine : 1u; nx = cnt > 0u ? cnt : 1u;
}
__device__ __forceinline__ void xcd_barrier(const XcdBarrier& b) {
    asm volatile("s_waitcnt vmcnt(0)" ::: "memory");
    __syncthreads();
    if (threadIdx.x == 0) {
        unsigned* bar = b.bar;
        __builtin_amdgcn_s_waitcnt(0);
        unsigned nloc = b.st[0], nx = b.st[1];
        if (nloc == 0u) { xcd_barrier_complete(bar, b.x, nloc, nx); b.st[0] = nloc; b.st[1] = nx; }
        const unsigned old = xb_add(&bar[XB_XSUB(b.x)], 1u);
        const unsigned gen = old / nloc;
        if (old + 1u == (gen + 1u) * nloc) {
            __builtin_amdgcn_fence(__ATOMIC_RELEASE, "agent");
            asm volatile("s_waitcnt vmcnt(0)" ::: "memory");
            const unsigned og = xb_add(&bar[XB_TOP], 1u);
            const unsigned tg = og / nx;
            if (og + 1u == (tg + 1u) * nx) xb_add(&bar[XB_TOPGEN], 1u);
            else XB_SPIN(xb_ld(&bar[XB_TOPGEN]) == tg, bar);
            __builtin_amdgcn_fence(__ATOMIC_ACQUIRE, "agent");
            xb_add(&bar[XB_XGEN(b.x)], 1u);
            asm volatile("s_waitcnt vmcnt(0)" ::: "memory");
        } else {
            XB_SPIN(xb_ld(&bar[XB_XGEN(b.x)]) == gen, bar);
            __builtin_amdgcn_fence(__ATOMIC_ACQUIRE, "agent");
            asm volatile("s_waitcnt vmcnt(0)" ::: "memory");
        }
    }
    __syncthreads();
}

struct Frame {
    LAS unsigned char* lds;
    int tid, lane, wave, vcu, G;
    long gtid, NT;
    int gw, NGW;
    const float* const* in; float* out; unsigned char* ws;
};

struct EmGU {
    bf16* HID; const float* RS;
    __device__ __forceinline__ void operator()(int gid, int row, int pn, int c8, const float (&a)[8], const float (&b)[8]) const {
        const float r = RS ? RS[row] : 1.f; float h[8];
#pragma unroll
        for (int j = 0; j < 8; ++j) h[j] = silu_f(r * a[j]) * (r * b[j]);
        *(v4u*)(HID + (size_t)row * DFF + 128 * pn + c8) = pack8(h);
    }
};
struct EmRes {
    const float* XIN; float* XF; bf16* XB; float scale;
    __device__ __forceinline__ void operator()(int gid, int row, int pn, int c8, const float (&a)[8], const float (&b)[8]) const {
#pragma unroll
        for (int hh = 0; hh < 2; ++hh) {
            const size_t off = (size_t)row * D + 256 * pn + 128 * hh + c8;
            const f32x4 x0 = *(const f32x4*)(XIN + off), x1 = *(const f32x4*)(XIN + off + 4);
            float o[8];
#pragma unroll
            for (int j = 0; j < 4; ++j) { o[j] = x0[j] + scale * (hh ? b[j] : a[j]); o[4 + j] = x1[j] + scale * (hh ? b[4 + j] : a[4 + j]); }
            *(f32x4*)(XF + off) = (f32x4){o[0], o[1], o[2], o[3]}; *(f32x4*)(XF + off + 4) = (f32x4){o[4], o[5], o[6], o[7]};
            if (XB) *(v4u*)(XB + off) = pack8(o);
        }
    }
};
struct EmIn {
    bf16 *Q, *KK, *V, *SG, *ZB, *P; float* LOGF; const float* RS; const float* LB;
    __device__ __forceinline__ void operator()(int gid, int row, int pn, int c8, const float (&a)[8], const float (&b)[8]) const {
        const float r = RS[row];
        if (pn >= 10) {
            float o[8];
#pragma unroll
            for (int j = 0; j < 8; ++j) o[j] = (r * a[j]) * (r * b[j]);
            *(v4u*)(P + (size_t)row * 512 + 128 * (pn - 10) + c8) = pack8(o);
            return;
        }
        const int kind = pn >> 1;
#pragma unroll
        for (int hh = 0; hh < 2; ++hh) {
            const int col = 256 * (pn & 1) + 128 * hh + c8; const size_t off = (size_t)row * 512 + col;
            float z[8], o[8];
#pragma unroll
            for (int j = 0; j < 8; ++j) z[j] = r * (hh ? b[j] : a[j]);
            if (kind == 0) {
#pragma unroll
                for (int j = 0; j < 8; ++j) o[j] = silu_f(z[j]) * 0.08838834764831845f;
                *(v4u*)(Q + off) = pack8(o);
            } else if (kind == 1) {
                float lf[8];
                const f32x4 l0 = *(const f32x4*)(LB + col), l1 = *(const f32x4*)(LB + col + 4);
#pragma unroll
                for (int j = 0; j < 8; ++j) { const float lb = j < 4 ? l0[j] : l1[j - 4]; const float f = lb + (1.f - lb) * sigm_f(z[j]); o[j] = 1.f - f; lf[j] = __logf(f); }
                *(v4u*)(KK + off) = pack8(o);
                *(f32x4*)(LOGF + off) = (f32x4){lf[0], lf[1], lf[2], lf[3]}; *(f32x4*)(LOGF + off + 4) = (f32x4){lf[4], lf[5], lf[6], lf[7]};
            } else if (kind == 2) { *(v4u*)(V + off) = pack8(z);
            } else if (kind == 3) {
#pragma unroll
                for (int j = 0; j < 8; ++j) o[j] = silu_f(z[j]);
                *(v4u*)(SG + off) = pack8(o);
            } else { *(v4u*)(ZB + off) = pack8(z); }
        }
    }
};
struct EmPlain {
    bf16* O; const float* RS; float scale;
    __device__ __forceinline__ void operator()(int gid, int row, int pn, int c8, const float (&a)[8], const float (&b)[8]) const {
        const float r = (RS ? RS[row] : 1.f) * scale; float o[8];
#pragma unroll
        for (int j = 0; j < 8; ++j) o[j] = r * a[j];
        *(v4u*)(O + (size_t)row * 1024 + 256 * pn + c8) = pack8(o);
#pragma unroll
        for (int j = 0; j < 8; ++j) o[j] = r * b[j];
        *(v4u*)(O + (size_t)row * 1024 + 256 * pn + 128 + c8) = pack8(o);
    }
};


namespace pg8 {
#define PG8_LAS __attribute__((address_space(3)))
typedef unsigned short bf16_t;
typedef short bf16x8 __attribute__((ext_vector_type(8)));
typedef unsigned u32x4 __attribute__((ext_vector_type(4)));
constexpr int BM = 256, BK = 64, HALF = 128, HTB = HALF * BK * 2, STAGE_BYTES = 8 * HTB, NXCD = 8, WGM = 8;
__host__ __device__ __forceinline__ int lds_byte(int r, int c) { const int st = (r >> 4) * 2 + (c >> 5), rr = r & 15, cc = c & 31, ob = rr * 64 + cc * 2; return st * 1024 + (ob ^ (((ob >> 9) & 1) << 5)); }
__host__ __device__ __forceinline__ void stage_rc(int b, int& R, int& C) { const int st = b / 1024, sb = b % 1024, swz = sb ^ (((sb >> 9) & 1) << 5); R = (st >> 1) * 16 + swz / 64; C = (st & 1) * 32 + (swz % 64) / 2; }
__host__ __device__ __forceinline__ int perm32(int rho) { const int n = rho >> 4, i = rho & 15; return 8 * (i >> 2) + 4 * n + (i & 3); }
struct Unit { int pm, pn, gid; };
__device__ __forceinline__ void order_map(int L, int nM, int nN, Unit& u) {
    const int nwg = nM * nN; int wgid = L; { const int q = nwg / NXCD, r = nwg % NXCD, xcd = wgid % NXCD, off = wgid / NXCD; wgid = (xcd < r ? xcd * (q + 1) : r * (q + 1) + (xcd - r) * q) + off; }
    const int nig = WGM * nN, gid = wgid / nig, fm = gid * WGM, gsz = (nM - fm) < WGM ? (nM - fm) : WGM;
    u.pm = fm + ((wgid % nig) % gsz); u.pn = (wgid % nig) / gsz;
}
struct Sched1 {
    const bf16_t* A; const bf16_t* Bt; int nM, nN, G, c;
    __device__ __forceinline__ bool next(int i, Unit& u) const { const long L = (long)i * G + c; if (c < 0 || L >= (long)nM * nN) return false; order_map((int)L, nM, nN, u); u.gid = 0; return true; }
    __device__ __forceinline__ const char* tileA(const Unit& u, size_t tstep) const { return (const char*)A + (size_t)u.pm * tstep; }
    __device__ __forceinline__ const char* tileB(const Unit& u, size_t tstep) const { return (const char*)Bt + (size_t)u.pn * tstep; }
    __device__ __forceinline__ void a_ready(const Unit&) const {}
    __device__ __forceinline__ void done(const Unit&) const {}
};
template <class Emit> struct EpiEmit {
    static constexpr bool PERM = true, AFTER_DRAIN = false; Emit E;
    __device__ __forceinline__ void operator()(const f32x4 (&acc)[2][2][4][2], const Unit& u, int wr, int wc, int fr, int fq) const {
#pragma unroll
        for (int ai = 0; ai < 2; ++ai)
#pragma unroll
            for (int m = 0; m < 4; ++m) {
                float a[8], b[8];
#pragma unroll
                for (int j = 0; j < 8; ++j) { a[j] = acc[ai][0][m][j >> 2][j & 3]; b[j] = acc[ai][1][m][j >> 2][j & 3]; }
                E(u.gid, u.pm * BM + ai * HALF + wr * 64 + m * 16 + fr, u.pn, wc * 32 + fq * 8, a, b);
            }
    }
};
template <class Epi, class Sched, bool ALIGN_EPI = false, bool SP2 = false>
__device__ __forceinline__ void gemm_phase(PG8_LAS unsigned char* lds, const int K, const Sched& S, const Epi& E) {
    const int tid = threadIdx.x, wid = __builtin_amdgcn_readfirstlane(tid >> 6), lane = tid & 63, wr = wid >> 2, wc = wid & 3, fr = lane & 15, fq = lane >> 4;
    const int nt = K / BK;
    unsigned voffA[2], voffB[2];
#pragma unroll
    for (int i = 0; i < 2; ++i) { int R, C; stage_rc(tid * 16 + i * 8192, R, C); const int Rb = Epi::PERM ? ((R & ~31) + perm32(R & 31)) : R;
        voffA[i] = (unsigned)(R * K + C) * 2u; voffB[i] = (unsigned)(Rb * K + C) * 2u; }
    const size_t kstep = (size_t)(BK * 2);
    const size_t hstep = (size_t)HALF * K * 2;
    const size_t tstep = 2 * hstep;
    const unsigned ldsw = (unsigned)wid * 1024u;
    const int aoff = lds_byte(wr * 64 + fr, fq * 8), boff = lds_byte(wc * 32 + fr, fq * 8);
#define PG8_SA(b, h) (((b) * 2 + (h)) * HTB)
#define PG8_SB(b, h) ((4 + (b) * 2 + (h)) * HTB)
#define PG8_STAGE(bufoff, gbase, voff) do { _Pragma("unroll") for (int _i = 0; _i < 2; ++_i) \
        __builtin_amdgcn_global_load_lds((const unsigned*)((const char*)(gbase) + (voff)[_i]), (PG8_LAS unsigned*)(lds + (bufoff) + ldsw + _i * 8192), 16, 0, 0); } while (0)
#define PG8_LDA(dst, b, h) do { _Pragma("unroll") for (int m = 0; m < 4; ++m) _Pragma("unroll") for (int k = 0; k < 2; ++k) dst[m][k] = *(const PG8_LAS bf16x8*)(lds + PG8_SA(b, h) + aoff + m * 2048 + k * 1024); } while (0)
#define PG8_LDB(dst, b, h) do { _Pragma("unroll") for (int n = 0; n < 2; ++n) _Pragma("unroll") for (int k = 0; k < 2; ++k) dst[n][k] = *(const PG8_LAS bf16x8*)(lds + PG8_SB(b, h) + boff + n * 2048 + k * 1024); } while (0)
#define PG8_MMA(ai, bj, At, Bt) do { __builtin_amdgcn_s_setprio(1); _Pragma("unroll") for (int m = 0; m < 4; ++m) _Pragma("unroll") for (int n = 0; n < 2; ++n) _Pragma("unroll") for (int k = 0; k < 2; ++k) \
        acc[ai][bj][m][n] = __builtin_amdgcn_mfma_f32_16x16x32_bf16(Bt[n][k], At[m][k], acc[ai][bj][m][n], 0, 0, 0); __builtin_amdgcn_s_setprio(0); } while (0)
#define PG8_WAIT_V(n) asm volatile("s_waitcnt vmcnt(" #n ")" ::: "memory")
#define PG8_WAIT_L(n) asm volatile("s_waitcnt lgkmcnt(" #n ")" ::: "memory")
#define PG8_BAR __builtin_amdgcn_s_barrier()
#define PG8_SCHED __builtin_amdgcn_sched_barrier(0)
    Unit cur, nxt; int ui = 0;
    if (!S.next(0, cur)) return;
    f32x4 acc[2][2][4][2];
#pragma unroll
    for (int a = 0; a < 2; ++a)
#pragma unroll
        for (int b = 0; b < 2; ++b)
#pragma unroll
            for (int m = 0; m < 4; ++m)
#pragma unroll
                for (int n = 0; n < 2; ++n) acc[a][b][m][n] = (f32x4){0.f, 0.f, 0.f, 0.f};
    bf16x8 At[4][2], B0[2][2], B1[2][2];
    const char* cA = S.tileA(cur, tstep); const char* cB = S.tileB(cur, tstep);
    S.a_ready(cur);
    if constexpr (SP2) {
        PG8_STAGE(PG8_SB(0, 0), cB, voffB); PG8_STAGE(PG8_SB(0, 1), cB + hstep, voffB); PG8_STAGE(PG8_SA(0, 0), cA, voffA); PG8_STAGE(PG8_SA(0, 1), cA + hstep, voffA);
        if (wr == 1) PG8_BAR;
        PG8_WAIT_V(2); PG8_BAR;
        PG8_STAGE(PG8_SB(1, 0), cB + kstep, voffB); PG8_STAGE(PG8_SA(1, 0), cA + kstep, voffA); PG8_STAGE(PG8_SB(1, 1), cB + hstep + kstep, voffB);
        PG8_WAIT_V(6); PG8_BAR;
    } else {
        PG8_STAGE(PG8_SB(0, 0), cB, voffB); PG8_STAGE(PG8_SA(0, 0), cA, voffA); PG8_STAGE(PG8_SB(0, 1), cB + hstep, voffB); PG8_STAGE(PG8_SA(0, 1), cA + hstep, voffA);
        if (wr == 1) PG8_BAR;
        PG8_WAIT_V(4); PG8_BAR;
        PG8_STAGE(PG8_SB(1, 0), cB + kstep, voffB); PG8_STAGE(PG8_SA(1, 0), cA + kstep, voffA); PG8_STAGE(PG8_SB(1, 1), cB + hstep + kstep, voffB);
        PG8_WAIT_V(6); PG8_BAR;
    }
    for (;;) {
        const bool has_next = S.next(ui + 1, nxt);
        const char* nA = has_next ? S.tileA(nxt, tstep) : cA; const char* nB = has_next ? S.tileB(nxt, tstep) : cB;
        for (int t = 0; t < nt; t += 2) {
            const bool last = (t == nt - 2);
            const char* a1 = cA + (size_t)(t + 1) * kstep;
            const char* a2 = last ? nA : cA + (size_t)(t + 2) * kstep; const char* b2 = last ? nB : cB + (size_t)(t + 2) * kstep;
            const char* a3 = a2 + kstep; const char* b3 = b2 + kstep;
            if (last && has_next) S.a_ready(nxt);
            if constexpr (SP2) {
            PG8_LDB(B0, 0, 0); PG8_LDB(B1, 0, 1); PG8_SCHED; PG8_LDA(At, 0, 0); PG8_STAGE(PG8_SA(1, 1), a1 + hstep, voffA);
            PG8_WAIT_V(8); PG8_WAIT_L(0); PG8_BAR; PG8_MMA(0, 0, At, B0); PG8_MMA(0, 1, At, B1); PG8_BAR; PG8_SCHED;
            PG8_LDA(At, 0, 1); PG8_STAGE(PG8_SB(0, 0), b2, voffB); PG8_STAGE(PG8_SB(0, 1), b2 + hstep, voffB); PG8_STAGE(PG8_SA(0, 0), a2, voffA);
            PG8_WAIT_V(8); PG8_WAIT_L(0); PG8_BAR; PG8_MMA(1, 0, At, B0); PG8_MMA(1, 1, At, B1); PG8_BAR; PG8_SCHED;
            PG8_LDB(B0, 1, 0); PG8_LDB(B1, 1, 1); PG8_SCHED; PG8_LDA(At, 1, 0); PG8_STAGE(PG8_SA(0, 1), a2 + hstep, voffA);
            PG8_WAIT_V(8); PG8_WAIT_L(0); PG8_BAR; PG8_MMA(0, 0, At, B0); PG8_MMA(0, 1, At, B1); PG8_BAR; PG8_SCHED;
            PG8_LDA(At, 1, 1); PG8_STAGE(PG8_SB(1, 0), b3, voffB); PG8_STAGE(PG8_SB(1, 1), b3 + hstep, voffB); PG8_STAGE(PG8_SA(1, 0), a3, voffA);
            PG8_WAIT_V(8); PG8_WAIT_L(0); PG8_BAR; PG8_MMA(1, 0, At, B0); PG8_MMA(1, 1, At, B1); PG8_BAR; PG8_SCHED;
            } else {
            PG8_LDB(B0, 0, 0); PG8_SCHED; PG8_LDA(At, 0, 0); PG8_STAGE(PG8_SA(1, 1), a1 + hstep, voffA);
            PG8_WAIT_L(8); PG8_BAR; PG8_WAIT_L(0); PG8_MMA(0, 0, At, B0); PG8_BAR; PG8_SCHED;
            PG8_LDB(B1, 0, 1); PG8_STAGE(PG8_SB(0, 0), b2, voffB);
            PG8_BAR; PG8_WAIT_L(0); PG8_MMA(0, 1, At, B1); PG8_BAR;
            PG8_LDA(At, 0, 1); PG8_STAGE(PG8_SA(0, 0), a2, voffA);
            PG8_BAR; PG8_WAIT_L(0); PG8_MMA(1, 0, At, B0); PG8_BAR; PG8_SCHED;
            PG8_STAGE(PG8_SB(0, 1), b2 + hstep, voffB);
            PG8_WAIT_V(6); PG8_BAR; PG8_MMA(1, 1, At, B1); PG8_BAR;
            PG8_LDB(B0, 1, 0); PG8_SCHED; PG8_LDA(At, 1, 0); PG8_STAGE(PG8_SA(0, 1), a2 + hstep, voffA);
            PG8_WAIT_L(8); PG8_BAR; PG8_WAIT_L(0); PG8_MMA(0, 0, At, B0); PG8_BAR; PG8_SCHED;
            PG8_LDB(B1, 1, 1); PG8_STAGE(PG8_SB(1, 0), b3, voffB);
            PG8_BAR; PG8_WAIT_L(0); PG8_MMA(0, 1, At, B1); PG8_BAR;
            PG8_LDA(At, 1, 1); PG8_STAGE(PG8_SA(1, 0), a3, voffA);
            PG8_BAR; PG8_WAIT_L(0); PG8_MMA(1, 0, At, B0); PG8_BAR; PG8_SCHED;
            PG8_STAGE(PG8_SB(1, 1), b3 + hstep, voffB);
            PG8_WAIT_V(6); PG8_BAR; PG8_MMA(1, 1, At, B1); PG8_BAR;
            }
        }
        if constexpr (ALIGN_EPI) { if (wr == 0) PG8_BAR; }
        if constexpr (!Epi::AFTER_DRAIN) { E(acc, cur, wr, wc, fr, fq); S.done(cur); }
        if (!has_next) break;
#pragma unroll
        for (int a = 0; a < 2; ++a)
#pragma unroll
            for (int b = 0; b < 2; ++b)
#pragma unroll
                for (int m = 0; m < 4; ++m)
#pragma unroll
                    for (int n = 0; n < 2; ++n) acc[a][b][m][n] = (f32x4){0.f, 0.f, 0.f, 0.f};
        cur = nxt; cA = nA; cB = nB; ++ui;
        if constexpr (ALIGN_EPI) { if (wr == 1) PG8_BAR; }
    }
    PG8_WAIT_V(0);
    if constexpr (!ALIGN_EPI) { if (wr == 0) PG8_BAR; }
    PG8_BAR;
    if constexpr (Epi::AFTER_DRAIN) { E.fused(acc, cur, wr, wc, fr, fq, lds, wid, lane); S.done(cur); }
#undef PG8_SA
#undef PG8_SB
#undef PG8_STAGE
#undef PG8_LDA
#undef PG8_LDB
#undef PG8_MMA
#undef PG8_WAIT_V
#undef PG8_WAIT_L
#undef PG8_BAR
#undef PG8_SCHED
}
}

template <class Emit>
__device__ __forceinline__ void naive_gemm(const Frame& F, const bf16* A, const bf16* Bt, int Mr, int N, int K, const Emit& E) {
    const long nitem = (long)Mr * (N / 256) * 16;
    for (long i = F.gtid; i < nitem; i += F.NT) {
        const int l = (int)(i & 63); const long g = i >> 6; const int rg = (int)(g % (Mr / 4)), pn = (int)(g / (Mr / 4));
        const int row = rg * 4 + (l >> 4), c8 = (l & 15) * 8;
        float a[8], b[8];
#pragma unroll
        for (int j = 0; j < 8; ++j) { a[j] = 0.f; b[j] = 0.f; }
        const bf16* ap = A + (size_t)row * K; const bf16* bp = Bt + (size_t)(256 * pn + c8) * K;
        for (int k = 0; k < K; k += 8) {
            float av[8]; unpack8(*(const v4u*)(ap + k), av);
#pragma unroll
            for (int j = 0; j < 8; ++j) {
                float bv[8]; unpack8(*(const v4u*)(bp + (size_t)j * K + k), bv);
                float cv[8]; unpack8(*(const v4u*)(bp + (size_t)(128 + j) * K + k), cv);
#pragma unroll
                for (int e = 0; e < 8; ++e) { a[j] += av[e] * bv[e]; b[j] += av[e] * cv[e]; }
            }
        }
        E(0, row, pn, c8, a, b);
    }
}

__device__ __forceinline__ void transpose_item(const float* W, int ldw, int col0, const float* g, bf16* WT, int Kd, int n0, int k0, LAS float* scr, int lane) {
#pragma unroll 8
    for (int i = 0; i < 32; ++i) { const int kk = 2 * i + (lane >> 5); const float gv = g ? g[k0 + kk] : 1.f; scr[kk * 33 + (lane & 31)] = W[(size_t)(k0 + kk) * ldw + col0 + (lane & 31)] * gv; }
    asm volatile("s_waitcnt lgkmcnt(0)" ::: "memory");
    const int c = lane & 7;
#pragma unroll
    for (int j = 0; j < 4; ++j) { const int n = (lane >> 3) + 8 * j; const LAS float* s = scr + (8 * c) * 33 + n;
        v4u o; o.x = pk2(s[0 * 33], s[1 * 33]); o.y = pk2(s[2 * 33], s[3 * 33]); o.z = pk2(s[4 * 33], s[5 * 33]); o.w = pk2(s[6 * 33], s[7 * 33]);
        *(v4u*)(WT + (size_t)(n0 + n) * Kd + k0 + 8 * c) = o; }
    asm volatile("s_waitcnt lgkmcnt(0)" ::: "memory");
}
__device__ __forceinline__ void norm_row_bf16(const float* xrow, const float* gain, bf16* orow, int lane) {
    const f32x4* xr = (const f32x4*)xrow + lane; f32x4 v[4]; float s = 0.f;
#pragma unroll
    for (int j = 0; j < 4; ++j) { v[j] = xr[64 * j]; s += (v[j].x * v[j].x + v[j].y * v[j].y) + (v[j].z * v[j].z + v[j].w * v[j].w); }
    const float r = 1.f / sqrtf(wave_sum(s) * (1.f / D) + EPS);
    v2u* o8 = (v2u*)orow + lane;
#pragma unroll
    for (int j = 0; j < 4; ++j) { f32x4 gg = gain ? ((const f32x4*)gain)[lane + 64 * j] : (f32x4){1.f, 1.f, 1.f, 1.f};
        v2u w; w.x = pk2(v[j].x * r * gg.x, v[j].y * r * gg.y); w.y = pk2(v[j].z * r * gg.z, v[j].w * r * gg.w); o8[64 * j] = w; }
}
__device__ __forceinline__ void p_prologue(const Frame& F) {
    LAS float* scr = (LAS float*)(F.lds + F.wave * 16384);
    unsigned char* ws = F.ws;
    constexpr int I_GU = 16 * (NGU / 32), I_D = (DFF / 64) * (D / 32), I_IN = 16 * (INC / 32), I_SQ = 16 * 32, I_KV = 16 * 64;
    constexpr int NITEMS = 2 * I_GU + 2 * I_D + I_IN + 3 * I_SQ + I_KV;
    for (int it = F.gw; it < NITEMS; it += F.NGW) {
        int r = it;
        if (r < 2 * I_GU) {
            const int which = r / I_GU; r -= which * I_GU; const int nb = r % (NGU / 32), kb = r / (NGU / 32), n0 = 32 * nb, t = n0 / 256, w = n0 % 256, half = w / 128, col = 128 * t + (w % 128);
            const float* W = F.in[(which ? 18 : 3) + half]; const float* g = F.in[which ? 17 : 2];
            transpose_item(W, DFF, col, g, (bf16*)(ws + (which ? WS_WGU2 : WS_WGU1)), D, n0, 64 * kb, scr, F.lane); continue; }
        r -= 2 * I_GU;
        if (r < 2 * I_D) { const int which = r / I_D; r -= which * I_D; const int nb = r % (D / 32), kb = r / (D / 32);
            transpose_item(F.in[which ? 20 : 5], D, 32 * nb, nullptr, (bf16*)(ws + (which ? WS_WD2 : WS_WD1)), DFF, 32 * nb, 64 * kb, scr, F.lane); continue; }
        r -= 2 * I_D;
        if (r < I_IN) { const int nb = r % (INC / 32), kb = r / (INC / 32), n0 = 32 * nb; int col = n0;
            if (n0 >= 2560) { const int t = (n0 - 2560) / 256, w = (n0 - 2560) % 256, half = w / 128; col = (half ? 3072 : 2560) + 128 * t + (w % 128); }
            transpose_item(F.in[7], INC, col, F.in[6], (bf16*)(ws + WS_WIN), D, n0, 64 * kb, scr, F.lane); continue; }
        r -= I_IN;
        if (r < 3 * I_SQ) { const int which = r / I_SQ; r -= which * I_SQ; const int nb = r % 32, kb = r / 32;
            const float* W = F.in[which == 0 ? 11 : (which == 1 ? 14 : 16)]; const float* g = which == 1 ? F.in[12] : nullptr;
            bf16* dst = (bf16*)(ws + (which == 0 ? WS_WOUT : (which == 1 ? WS_WQ : WS_WO)));
            transpose_item(W, D, 32 * nb, g, dst, D, 32 * nb, 64 * kb, scr, F.lane); continue; }
        r -= 3 * I_SQ;
        { const int nb = r % 64, kb = r / 64; transpose_item(F.in[15], 2 * D, 32 * nb, nullptr, (bf16*)(ws + WS_WKV), D, 32 * nb, 64 * kb, scr, F.lane); }
    }
    for (int m = F.gw; m < M; m += F.NGW) norm_row_bf16(F.in[0] + (size_t)m * D, nullptr, (bf16*)(ws + WS_XN) + (size_t)m * D, F.lane);
    for (int m = F.gw; m < MROWS; m += F.NGW) norm_row_bf16(F.in[1] + (size_t)m * D, F.in[13], (bf16*)(ws + WS_MN) + (size_t)m * D, F.lane);
    if (F.gtid < HF) { const float p0 = F.in[8][F.gtid], p1 = F.in[8][HF + F.gtid]; const float mx = fmaxf(p0, p1), e0 = __expf(p0 - mx), e1 = __expf(p1 - mx);
        ((float*)(ws + WS_LB))[F.gtid] = e0 / (e0 + e1); }
}

__device__ __forceinline__ void p_rowstat(const Frame& F) {
    float* RS = (float*)(F.ws + WS_RS);
    for (int m = F.gw; m < M; m += F.NGW) {
        const f32x4* xr = (const f32x4*)(F.out + (size_t)m * D) + F.lane; float s = 0.f;
#pragma unroll
        for (int j = 0; j < 4; ++j) { const f32x4 v = xr[64 * j]; s += (v.x * v.x + v.y * v.y) + (v.z * v.z + v.w * v.w); }
        s = wave_sum(s);
        if (F.lane == 0) RS[m] = 1.f / sqrtf(s * (1.f / D) + EPS);
    }
}
__device__ __forceinline__ void p_final(const Frame& F) {
    const float* g = F.in[21];
    for (int m = F.gw; m < M; m += F.NGW) {
        f32x4* xr = (f32x4*)(F.out + (size_t)m * D) + F.lane; f32x4 v[4]; float s = 0.f;
#pragma unroll
        for (int j = 0; j < 4; ++j) { v[j] = xr[64 * j]; s += (v[j].x * v[j].x + v[j].y * v[j].y) + (v[j].z * v[j].z + v[j].w * v[j].w); }
        const float r = 1.f / sqrtf(wave_sum(s) * (1.f / D) + EPS);
#pragma unroll
        for (int j = 0; j < 4; ++j) { const f32x4 gg = ((const f32x4*)g)[F.lane + 64 * j]; xr[64 * j] = (f32x4){v[j].x * r * gg.x, v[j].y * r * gg.y, v[j].z * r * gg.z, v[j].w * r * gg.w}; }
    }
}

__device__ __forceinline__ void p_conv(const Frame& F) {
    const bf16* ZB = (const bf16*)(F.ws + WS_ZB); const bf16* P = (const bf16*)(F.ws + WS_P); bf16* Y = (bf16*)(F.ws + WS_Y); const float* cw = F.in[10];
    const long nitem = (long)M * 64;
    for (long i = F.gtid; i < nitem; i += F.NT) {
        const int row = (int)(i >> 6), c8 = (int)(i & 63) * 8, t = row % SEQ;
        float zb[8], p0[8], p1[8], p2[8], o[8];
        unpack8(*(const v4u*)(ZB + (size_t)row * 512 + c8), zb);
        unpack8(*(const v4u*)(P + (size_t)row * 512 + c8), p2);
        if (t >= 1) unpack8(*(const v4u*)(P + (size_t)(row - 1) * 512 + c8), p1); else {
#pragma unroll
            for (int j = 0; j < 8; ++j) p1[j] = 0.f; }
        if (t >= 2) unpack8(*(const v4u*)(P + (size_t)(row - 2) * 512 + c8), p0); else {
#pragma unroll
            for (int j = 0; j < 8; ++j) p0[j] = 0.f; }
#pragma unroll
        for (int j = 0; j < 8; ++j) { const float* w = cw + (c8 + j) * 3; o[j] = zb[j] * (w[0] * p0[j] + w[1] * p1[j] + w[2] * p2[j]); }
        *(v4u*)(Y + (size_t)row * D + 512 + c8) = pack8(o);
    }
}

__device__ __forceinline__ void p_scan_simple(const Frame& F) {
    const bf16* Q = (const bf16*)(F.ws + WS_Q); const bf16* KK = (const bf16*)(F.ws + WS_KK); const bf16* V = (const bf16*)(F.ws + WS_V); const float* LOGF = (const float*)(F.ws + WS_LOGF);
    float* O32 = (float*)(F.ws + WS_DS);
    if (F.gtid < BATCH * NH * DV) {
    const int dv = (int)(F.gtid % DV), h = (int)(F.gtid / DV) % NH, b = (int)(F.gtid / (DV * NH));
    float S[DK];
#pragma unroll
    for (int i = 0; i < DK; ++i) S[i] = 0.f;
    for (int t = 0; t < SEQ; ++t) {
        const size_t rb = ((size_t)b * SEQ + t) * 512 + h * 128;
        const float v = bf2f(V[rb + dv]); float o = 0.f;
#pragma unroll
        for (int i8 = 0; i8 < DK / 8; ++i8) {
            float q[8], k[8]; unpack8(*(const v4u*)(Q + rb + 8 * i8), q); unpack8(*(const v4u*)(KK + rb + 8 * i8), k);
            const f32x4 l0 = *(const f32x4*)(LOGF + rb + 8 * i8), l1 = *(const f32x4*)(LOGF + rb + 8 * i8 + 4);
#pragma unroll
            for (int j = 0; j < 8; ++j) { const float f = __expf(j < 4 ? l0[j] : l1[j - 4]); S[8 * i8 + j] = f * S[8 * i8 + j] + k[j] * v; o += S[8 * i8 + j] * q[j]; }
        }
        O32[((size_t)b * SEQ + t) * 512 + h * 128 + dv] = o;
    }
    }
}
__device__ __forceinline__ void p_hnorm_simple(const Frame& F) {
    const float* O32 = (const float*)(F.ws + WS_DS); const bf16* SG = (const bf16*)(F.ws + WS_SG); bf16* Y = (bf16*)(F.ws + WS_Y); const float* g = F.in[9];
    for (int it = F.gw; it < M * NH; it += F.NGW) {
        const int row = it >> 2, h = it & 3; const size_t off = (size_t)row * 512 + h * 128 + 2 * F.lane;
        const float o0 = O32[off], o1 = O32[off + 1];
        const float r = 1.f / sqrtf(wave_sum(o0 * o0 + o1 * o1) * (1.f / DV) + EPS);
        const unsigned sg = *(const unsigned*)(SG + off);
        *(unsigned*)(Y + (size_t)row * D + h * 128 + 2 * F.lane) = pk2(o0 * r * g[h * 128 + 2 * F.lane] * bflo(sg), o1 * r * g[h * 128 + 2 * F.lane + 1] * bfhi(sg));
    }
}

__device__ __forceinline__ void p_attn_simple(const Frame& F) {
    const bf16* QM = (const bf16*)(F.ws + WS_QM); const bf16* KM = (const bf16*)(F.ws + WS_KM); const bf16* VMT = (const bf16*)(F.ws + WS_VMT); bf16* ATT = (bf16*)(F.ws + WS_ATT);
    const int lane = F.lane;
    for (int it = F.gw; it < M * MH; it += F.NGW) {
        const int row = it >> 2, h = it & 3, b = row / SEQ;
        const v2u qw = *(const v2u*)(QM + (size_t)row * D + h * MHD + 4 * lane);
        const float q0 = bflo(qw.x), q1 = bfhi(qw.x), q2 = bflo(qw.y), q3 = bfhi(qw.y);
        float sc[4];
#pragma unroll
        for (int jj = 0; jj < 4; ++jj) {
            float mine = 0.f;
            for (int jl = 0; jl < 64; ++jl) {
                const v2u kw = *(const v2u*)(KM + (size_t)(b * MEML + jj * 64 + jl) * D + h * MHD + 4 * lane);
                const float s = wave_sum(q0 * bflo(kw.x) + q1 * bfhi(kw.x) + q2 * bflo(kw.y) + q3 * bfhi(kw.y));
                if (lane == jl) mine = s;
            }
            sc[jj] = mine;
        }
        const float mx = wave_max(fmaxf(fmaxf(sc[0], sc[1]), fmaxf(sc[2], sc[3])));
        float l = 0.f;
#pragma unroll
        for (int jj = 0; jj < 4; ++jj) { sc[jj] = __expf(sc[jj] - mx); l += sc[jj]; }
        const float inv = 1.f / wave_sum(l);
        float acc[4] = {0.f, 0.f, 0.f, 0.f};
#pragma unroll
        for (int jj = 0; jj < 4; ++jj)
            for (int jc = 0; jc < 8; ++jc) {
                float p[8];
#pragma unroll
                for (int e = 0; e < 8; ++e) p[e] = __shfl(sc[jj], jc * 8 + e);
#pragma unroll
                for (int i = 0; i < 4; ++i) { float vv[8]; unpack8(*(const v4u*)(VMT + (size_t)(h * MHD + 4 * lane + i) * MROWS + b * MEML + jj * 64 + jc * 8), vv);
#pragma unroll
                    for (int e = 0; e < 8; ++e) acc[i] += p[e] * vv[e]; }
            }
        v2u o; o.x = pk2(acc[0] * inv, acc[1] * inv); o.y = pk2(acc[2] * inv, acc[3] * inv);
        *(v2u*)(ATT + (size_t)row * D + h * MHD + 4 * lane) = o;
    }
}


#ifndef OPT_MASK
#define OPT_MASK 255
#endif
#define GEMM1(bit, multi, Ap, Bp, Mr, Nn, Kk, EmT, emv) GEMM1C(bit, multi, (int)blockIdx.x, Ap, Bp, Mr, Nn, Kk, EmT, emv)
#define GEMM1C(bit, multi, cc, Ap, Bp, Mr, Nn, Kk, EmT, emv) do { if constexpr ((OPT_MASK & (bit)) != 0) { \
        pg8::Sched1 S_{(Ap), (Bp), (Mr) / 256, (Nn) / 256, F.G, (cc)}; pg8::EpiEmit<EmT> E_{emv}; \
        pg8::gemm_phase<pg8::EpiEmit<EmT>, pg8::Sched1, multi, true>(F.lds, (Kk), S_, E_); \
    } else { naive_gemm(F, (Ap), (Bp), (Mr), (Nn), (Kk), emv); } } while (0)

struct Args { const float* in[22]; float* out; unsigned char* ws; int ph_lo, ph_hi; };
__global__ void __launch_bounds__(NTHR, 2) fwd(Args args) {
    extern __shared__ __attribute__((aligned(16))) unsigned char lds[];
    Frame F;
    F.lds = (LAS unsigned char*)lds;
    F.tid = threadIdx.x; F.lane = F.tid & 63; F.wave = __builtin_amdgcn_readfirstlane(F.tid >> 6);
    F.G = gridDim.x; { const int bx = blockIdx.x; F.vcu = (F.G % 8 == 0) ? (bx % 8) * (F.G / 8) + bx / 8 : bx; }
    F.gtid = (long)F.vcu * NTHR + F.tid; F.NT = (long)F.G * NTHR; F.gw = F.vcu * NWAVES + F.wave; F.NGW = F.G * NWAVES;
    F.in = args.in;
    F.out = args.out; F.ws = args.ws;
    unsigned char* ws = args.ws;
    const int lo = args.ph_lo, hi = args.ph_hi;
    for (int u = F.tid; u < (LDS_BYTES - LDSCTL_OFF) / 4; u += NTHR) ((LAS unsigned*)(F.lds + LDSCTL_OFF))[u] = 0u;
    __syncthreads();
    XcdBarrier bar; bar.bar = (unsigned*)(ws + WS_CTL) + CW_BAR; bar.x = 0; bar.st = nullptr;
    if (hi - lo > 1) bar = xcd_barrier_post((unsigned*)(ws + WS_CTL) + CW_BAR, (volatile LAS unsigned*)(F.lds + MISC_OFF) + 8);
#define IN(k) (lo <= (k) && (k) < hi)
#define SEAM(k) do { if (IN(k) && IN((k) + 1)) xcd_barrier(bar); } while (0)
    const float* RS = (const float*)(ws + WS_RS);
    if (IN(0)) p_prologue(F);
    SEAM(0);
    if (IN(1)) {
        GEMM1(1, true, (const bf16*)(ws + WS_XN), (const bf16*)(ws + WS_WGU1), M, NGU, D, EmGU, (EmGU{(bf16*)(ws + WS_HID), nullptr}));
        GEMM1C(1, false, (int)blockIdx.x - 128, (const bf16*)(ws + WS_MN), (const bf16*)(ws + WS_WKV), MROWS, D, D, EmPlain, (EmPlain{(bf16*)(ws + WS_KM), nullptr, 1.f}));
        GEMM1C(1, false, (int)blockIdx.x - 144, (const bf16*)(ws + WS_WKV) + (size_t)D * D, (const bf16*)(ws + WS_MN), D, MROWS, D, EmPlain, (EmPlain{(bf16*)(ws + WS_VMT), nullptr, 1.f}));
    }
    SEAM(1);
    if (IN(2)) GEMM1(2, false, (const bf16*)(ws + WS_HID), (const bf16*)(ws + WS_WD1), M, D, DFF, EmRes, (EmRes{F.in[0], F.out, (bf16*)(ws + WS_XB), 0.5f}));
    SEAM(2);
    if (IN(3)) p_rowstat(F);
    SEAM(3);
    if (IN(4)) GEMM1(4, true, (const bf16*)(ws + WS_XB), (const bf16*)(ws + WS_WIN), M, INC, D, EmIn,
                     (EmIn{(bf16*)(ws + WS_Q), (bf16*)(ws + WS_KK), (bf16*)(ws + WS_V), (bf16*)(ws + WS_SG), (bf16*)(ws + WS_ZB), (bf16*)(ws + WS_P), (float*)(ws + WS_LOGF), RS, (const float*)(ws + WS_LB)}));
    SEAM(4);
    if (IN(5)) { p_conv(F); p_scan_simple(F); }
    SEAM(5);
    if (IN(6)) {}
    SEAM(6);
    if (IN(7)) p_hnorm_simple(F);
    SEAM(7);
    if (IN(8)) GEMM1(8, false, (const bf16*)(ws + WS_Y), (const bf16*)(ws + WS_WOUT), M, D, D, EmRes, (EmRes{F.out, F.out, (bf16*)(ws + WS_XB2), 1.f}));
    SEAM(8);
    if (IN(9)) p_rowstat(F);
    SEAM(9);
    if (IN(10)) GEMM1(16, false, (const bf16*)(ws + WS_XB2), (const bf16*)(ws + WS_WQ), M, D, D, EmPlain, (EmPlain{(bf16*)(ws + WS_QM), RS, 0.0625f}));
    SEAM(10);
    if (IN(11)) p_attn_simple(F);
    SEAM(11);
    if (IN(12)) GEMM1(32, false, (const bf16*)(ws + WS_ATT), (const bf16*)(ws + WS_WO), M, D, D, EmRes, (EmRes{F.out, F.out, (bf16*)(ws + WS_XB2), 1.f}));
    SEAM(12);
    if (IN(13)) p_rowstat(F);
    SEAM(13);
    if (IN(14)) GEMM1(64, true, (const bf16*)(ws + WS_XB2), (const bf16*)(ws + WS_WGU2), M, NGU, D, EmGU, (EmGU{(bf16*)(ws + WS_HID), RS}));
    SEAM(14);
    if (IN(15)) GEMM1(128, false, (const bf16*)(ws + WS_HID), (const bf16*)(ws + WS_WD2), M, D, DFF, EmRes, (EmRes{F.out, F.out, nullptr, 0.5f}));
    SEAM(15);
    if (IN(16)) p_final(F);
#undef IN
#undef SEAM
}

extern "C" void kernel_launch(void* const* d_in, const int* in_sizes, int n_in, void* d_out, int out_size, void* d_ws, size_t ws_size, hipStream_t stream) {
    static int grid = 0;
    if (grid == 0) {
        if (n_in != 22 || in_sizes[0] != M * D || out_size != M * D || ws_size < WS_END) { fprintf(stderr, "kernel_launch: unexpected shapes (n_in %d, in0 %d, out %d, ws %zu)\n", n_in, n_in > 0 ? in_sizes[0] : -1, out_size, ws_size); grid = -1; return; }
        int dev = 0, cus = 0;
        if (hipGetDevice(&dev) != hipSuccess || hipDeviceGetAttribute(&cus, hipDeviceAttributeMultiprocessorCount, dev) != hipSuccess) { grid = -1; return; }
        if (hipFuncSetAttribute((const void*)fwd, hipFuncAttributeMaxDynamicSharedMemorySize, LDS_BYTES) != hipSuccess) { fprintf(stderr, "kernel_launch: hipFuncSetAttribute failed\n"); grid = -1; return; }
        grid = cus;
    }
    if (grid < 0) return;
    Args a{};
    for (int i = 0; i < 22; ++i) a.in[i] = (const float*)d_in[i];
    a.out = (float*)d_out; a.ws = (unsigned char*)d_ws;
    if (hipMemsetAsync((char*)d_ws + WS_CTL, 0, CTL_ZERO_BYTES, stream) != hipSuccess) { fprintf(stderr, "kernel_launch: memset failed\n"); return; }
    a.ph_lo = 0; a.ph_hi = NPHASE;
    void* kargs[] = {&a};
    hipError_t e = hipLaunchCooperativeKernel((const void*)fwd, dim3(grid), dim3(NTHR), kargs, LDS_BYTES, stream);
    if (e != hipSuccess) fprintf(stderr, "kernel_launch: cooperative launch failed: %s (grid %d)\n", hipGetErrorString(e), grid);
}
```

```cpp
#include <hip/hip_runtime.h>
#include <cstdio>
#include <cstdint>

#define GAS __attribute__((address_space(1)))
#define LAS __attribute__((address_space(3)))
typedef unsigned short bf16;
typedef unsigned v4u __attribute__((ext_vector_type(4)));
typedef unsigned v2u __attribute__((ext_vector_type(2)));
typedef float f32x4 __attribute__((ext_vector_type(4)));

constexpr int BATCH = 4, SEQ = 4096, D = 1024, M = BATCH * SEQ, DFF = 2816, NGU = 2 * DFF, INC = 3584;
constexpr int HF = 512, NH = 4, DK = 128, DV = 128, CHUNK = 64, NCHUNK = SEQ / CHUNK;
constexpr int MEML = 256, MH = 4, MHD = 256, MROWS = BATCH * MEML;
constexpr float EPS = 1e-6f;
constexpr int NWAVES = 8, NTHR = NWAVES * 64;
constexpr int NPHASE = 17;

constexpr size_t MiB = 1u << 20;
constexpr size_t WS_CTL = 0, CTL_ZERO_BYTES = 1 * MiB;
constexpr size_t WS_LB = 1 * MiB, WS_RS = 1 * MiB + 65536;
constexpr size_t WS_WGU1 = 2 * MiB, WS_WD1 = 13 * MiB, WS_WIN = WS_WD1 + 5 * MiB + 512 * 1024, WS_WOUT = WS_WIN + 7 * MiB, WS_WQ = WS_WOUT + 2 * MiB,
                 WS_WKV = WS_WQ + 2 * MiB, WS_WO = WS_WKV + 4 * MiB, WS_WGU2 = WS_WO + 2 * MiB, WS_WD2 = WS_WGU2 + 11 * MiB, WS_MN = 52 * MiB, WS_KM = 54 * MiB, WS_VMT = 56 * MiB,
                 WS_DEC = 58 * MiB;
static_assert(WS_WD2 + 5 * MiB + 512 * 1024 == WS_MN, "weight map");
constexpr size_t WS_XN = 64 * MiB, WS_HID = 96 * MiB, WS_XB = 216 * MiB;
constexpr size_t WS_Q = 64 * MiB, WS_KK = 80 * MiB, WS_LOGF = 96 * MiB, WS_V = 128 * MiB, WS_SG = 144 * MiB, WS_ZB = 160 * MiB, WS_P = 176 * MiB, WS_DS = 192 * MiB, WS_Y = 224 * MiB;
constexpr size_t WS_XB2 = 64 * MiB, WS_QM = 96 * MiB, WS_ATT = 128 * MiB, WS_END = 256 * MiB;

constexpr int RING_BYTES = 131072, LDSCTL_OFF = RING_BYTES, MISC_OFF = LDSCTL_OFF + 320, LDS_BYTES = 147456;

__device__ __forceinline__ unsigned f2bf(float f) { unsigned u = __builtin_bit_cast(unsigned, f); return (u + 0x7fffu + ((u >> 16) & 1u)) >> 16; }
__device__ __forceinline__ unsigned pk2(float lo, float hi) { return f2bf(lo) | (f2bf(hi) << 16); }
__device__ __forceinline__ float bflo(unsigned w) { return __builtin_bit_cast(float, w << 16); }
__device__ __forceinline__ float bfhi(unsigned w) { return __builtin_bit_cast(float, w & 0xffff0000u); }
__device__ __forceinline__ float bf2f(bf16 b) { return __builtin_bit_cast(float, (unsigned)b << 16); }
__device__ __forceinline__ float wave_sum(float v) {
#pragma unroll
    for (int o = 1; o < 64; o <<= 1) v += __shfl_xor(v, o);
    return v;
}
__device__ __forceinline__ float wave_max(float v) {
#pragma unroll
    for (int o = 1; o < 64; o <<= 1) v = fmaxf(v, __shfl_xor(v, o));
    return v;
}
__device__ __forceinline__ float silu_f(float x) { return x / (1.f + __expf(-x)); }
__device__ __forceinline__ float sigm_f(float x) { return 1.f / (1.f + __expf(-x)); }
__device__ __forceinline__ void unpack8(v4u w, float (&f)[8]) {
    f[0] = bflo(w.x); f[1] = bfhi(w.x); f[2] = bflo(w.y); f[3] = bfhi(w.y); f[4] = bflo(w.z); f[5] = bfhi(w.z); f[6] = bflo(w.w); f[7] = bfhi(w.w);
}
__device__ __forceinline__ v4u pack8(const float (&f)[8]) { v4u w; w.x = pk2(f[0], f[1]); w.y = pk2(f[2], f[3]); w.z = pk2(f[4], f[5]); w.w = pk2(f[6], f[7]); return w; }


typedef GAS unsigned gu32;
constexpr int CW_TMO = 0, CW_CODE = 1, CW_BAR = 4096;
#define XB_TMO      128
#define XB_XCNT(j)  (256  + 64 * (j))
#define XB_XSUB(j)  (1280 + 64 * (j))
#define XB_XGEN(j)  (2304 + 64 * (j))
#define XB_TOP      3328
#define XB_TOPGEN   3392
#define XCD_BAR_WORDS 3456
#define XB_SPIN_CAP (1u << 18)
__device__ __forceinline__ unsigned xb_ld(unsigned* p)              { return __hip_atomic_load(p, __ATOMIC_RELAXED, __HIP_MEMORY_SCOPE_AGENT); }
__device__ __forceinline__ unsigned xb_add(unsigned* p, unsigned v) { return __hip_atomic_fetch_add(p, v, __ATOMIC_RELAXED, __HIP_MEMORY_SCOPE_AGENT); }
__device__ __forceinline__ unsigned xb_xcc_id() { return (unsigned)__builtin_amdgcn_s_getreg((3 << 11) | 20) & 0xFu; }
#define XB_SPIN(cond, bar) do { unsigned _sp = 0; while (cond) { __builtin_amdgcn_s_sleep(1); \
    if ((++_sp & 255u) == 0u) { if (xb_ld(&(bar)[XB_TMO])) break; if (_sp > XB_SPIN_CAP) { atomicAdd(&(bar)[XB_TMO], 1u); break; } } } } while (0)
struct XcdBarrier { unsigned* bar; unsigned x; volatile LAS unsigned* st; };
__device__ __forceinline__ XcdBarrier xcd_barrier_post(unsigned* bar, volatile LAS unsigned* st) {
    XcdBarrier b; b.bar = bar; b.x = xb_xcc_id(); b.st = st;
    if (threadIdx.x == 0) (void)xb_add(&bar[XB_XCNT(b.x)], 1u);
    return b;
}
__device__ __forceinline__ void xcd_barrier_complete(unsigned* bar, unsigned x, unsigned& nloc, unsigned& nx) {
    const unsigned G = gridDim.x * gridDim.y * gridDim.z;
    unsigned sum, cnt, mine, sp = 0u;
    for (;;) {
        sum = 0u; cnt = 0u; mine = 0u;
#pragma unroll
        for (unsigned j = 0; j < 16; ++j) { const unsigned c = xb_ld(&bar[XB_XCNT(j)]); sum += c; cnt += (c > 0u) ? 1u : 0u; mine = (j == x) ? c : mine; }
        if (sum == G) break;
        __builtin_amdgcn_s_sleep(1);
        if ((++sp & 255u) == 0u) { if (xb_ld(&bar[XB_TMO])) break; if (sp > XB_SPIN_CAP) { atomicAdd(&bar[XB_TMO], 1u); break; } }
    }
    nloc = mine > 0u ? mine : 1u; nx = cnt > 0u ? cnt : 1u;
}
__device__ __forceinline__ void xcd_barrier(const XcdBarrier& b) {
    asm volatile("s_waitcnt vmcnt(0)" ::: "memory");
    __syncthreads();
    if (threadIdx.x == 0) {
        unsigned* bar = b.bar;
        __builtin_amdgcn_s_waitcnt(0);
        unsigned nloc = b.st[0], nx = b.st[1];
        if (nloc == 0u) { xcd_barrier_complete(bar, b.x, nloc, nx); b.st[0] = nloc; b.st[1] = nx; }
        const unsigned old = xb_add(&bar[XB_XSUB(b.x)], 1u);
        const unsigned gen = old / nloc;
        if (old + 1u == (gen + 1u) * nloc) {
            __builtin_amdgcn_fence(__ATOMIC_RELEASE, "agent");
            asm volatile("s_waitcnt vmcnt(0)" ::: "memory");
            const unsigned og = xb_add(&bar[XB_TOP], 1u);
            const unsigned tg = og / nx;
            if (og + 1u == (tg + 1u) * nx) xb_add(&bar[XB_TOPGEN], 1u);
            else XB_SPIN(xb_ld(&bar[XB_TOPGEN]) == tg, bar);
            __builtin_amdgcn_fence(__ATOMIC_ACQUIRE, "agent");
            xb_add(&bar[XB_XGEN(b.x)], 1u);
            asm volatile("s_waitcnt vmcnt(0)" ::: "memory");
        } else {
            XB_SPIN(xb_ld(&bar[XB_XGEN(b.x)]) == gen, bar);
            __builtin_amdgcn_fence(__ATOMIC_ACQUIRE, "agent");
            asm volatile("s_waitcnt vmcnt(0)" ::: "memory");
        }
    }
    __syncthreads();
}

struct Frame {
    LAS unsigned char* lds;
    int tid, lane, wave, vcu, G;
    long gtid, NT;
    int gw, NGW;
    const float* const* in; float* out; unsigned char* ws;
};

struct EmGU {
    bf16* HID; const float* RS;
    __device__ __forceinline__ void operator()(int gid, int row, int pn, int c8, const float (&a)[8], const float (&b)[8]) const {
        const float r = RS ? RS[row] : 1.f; float h[8];
#pragma unroll
        for (int j = 0; j < 8; ++j) h[j] = silu_f(r * a[j]) * (r * b[j]);
        *(v4u*)(HID + (size_t)row * DFF + 128 * pn + c8) = pack8(h);
    }
};
struct EmRes {
    const float* XIN; float* XF; bf16* XB; float scale;
    __device__ __forceinline__ void operator()(int gid, int row, int pn, int c8, const float (&a)[8], const float (&b)[8]) const {
#pragma unroll
        for (int hh = 0; hh < 2; ++hh) {
            const size_t off = (size_t)row * D + 256 * pn + 128 * hh + c8;
            const f32x4 x0 = *(const f32x4*)(XIN + off), x1 = *(const f32x4*)(XIN + off + 4);
            float o[8];
#pragma unroll
            for (int j = 0; j < 4; ++j) { o[j] = x0[j] + scale * (hh ? b[j] : a[j]); o[4 + j] = x1[j] + scale * (hh ? b[4 + j] : a[4 + j]); }
            *(f32x4*)(XF + off) = (f32x4){o[0], o[1], o[2], o[3]}; *(f32x4*)(XF + off + 4) = (f32x4){o[4], o[5], o[6], o[7]};
            if (XB) *(v4u*)(XB + off) = pack8(o);
        }
    }
};
struct EmInA {
    bf16 *SG, *ZB, *P; const float* RS;
    __device__ __forceinline__ void operator()(int gid, int row, int pn, int c8, const float (&a)[8], const float (&b)[8]) const {
        const float r = RS[row];
        if (pn >= 4) {
            float o[8];
#pragma unroll
            for (int j = 0; j < 8; ++j) o[j] = (r * a[j]) * (r * b[j]);
            *(v4u*)(P + (size_t)row * 512 + 128 * (pn - 4) + c8) = pack8(o);
            return;
        }
#pragma unroll
        for (int hh = 0; hh < 2; ++hh) {
            const size_t off = (size_t)row * 512 + 256 * (pn & 1) + 128 * hh + c8;
            float z[8];
#pragma unroll
            for (int j = 0; j < 8; ++j) z[j] = r * (hh ? b[j] : a[j]);
            if (pn < 2) {
#pragma unroll
                for (int j = 0; j < 8; ++j) z[j] = silu_f(z[j]);
                *(v4u*)(SG + off) = pack8(z);
            } else *(v4u*)(ZB + off) = pack8(z);
        }
    }
};
struct EmInB {
    bf16 *QT, *KT, *VT; float* LOGFT; const float* RS; const float* LB;
    __device__ __forceinline__ void operator()(int gid, int row, int pn, int c8, const float (&a)[8], const float (&b)[8]) const {
        const int kind = row >> 9, ch = row & 511;
        const float lb = LB[ch];
#pragma unroll
        for (int hh = 0; hh < 2; ++hh) {
            const int tok = 256 * pn + 128 * hh + c8; const size_t off = (size_t)ch * M + tok;
            const f32x4 r0 = *(const f32x4*)(RS + tok), r1 = *(const f32x4*)(RS + tok + 4);
            float z[8], o[8];
#pragma unroll
            for (int j = 0; j < 8; ++j) z[j] = (j < 4 ? r0[j] : r1[j - 4]) * (hh ? b[j] : a[j]);
            if (kind == 0) {
#pragma unroll
                for (int j = 0; j < 8; ++j) o[j] = silu_f(z[j]) * 0.08838834764831845f;
                *(v4u*)(QT + off) = pack8(o);
            } else if (kind == 1) {
                float lf[8];
#pragma unroll
                for (int j = 0; j < 8; ++j) { const float f = lb + (1.f - lb) * sigm_f(z[j]); o[j] = 1.f - f; lf[j] = __logf(f); }
                *(v4u*)(KT + off) = pack8(o);
                *(f32x4*)(LOGFT + off) = (f32x4){lf[0], lf[1], lf[2], lf[3]}; *(f32x4*)(LOGFT + off + 4) = (f32x4){lf[4], lf[5], lf[6], lf[7]};
            } else *(v4u*)(VT + off) = pack8(z);
        }
    }
};
struct EmPlain {
    bf16* O; const float* RS; float scale;
    __device__ __forceinline__ void operator()(int gid, int row, int pn, int c8, const float (&a)[8], const float (&b)[8]) const {
        const float r = (RS ? RS[row] : 1.f) * scale; float o[8];
#pragma unroll
        for (int j = 0; j < 8; ++j) o[j] = r * a[j];
        *(v4u*)(O + (size_t)row * 1024 + 256 * pn + c8) = pack8(o);
#pragma unroll
        for (int j = 0; j < 8; ++j) o[j] = r * b[j];
        *(v4u*)(O + (size_t)row * 1024 + 256 * pn + 128 + c8) = pack8(o);
    }
};


namespace pg8 {
#define PG8_LAS __attribute__((address_space(3)))
typedef unsigned short bf16_t;
typedef short bf16x8 __attribute__((ext_vector_type(8)));
typedef unsigned u32x4 __attribute__((ext_vector_type(4)));
constexpr int BM = 256, BK = 64, HALF = 128, HTB = HALF * BK * 2, STAGE_BYTES = 8 * HTB, NXCD = 8, WGM = 8;
__host__ __device__ __forceinline__ int lds_byte(int r, int c) { const int st = (r >> 4) * 2 + (c >> 5), rr = r & 15, cc = c & 31, ob = rr * 64 + cc * 2; return st * 1024 + (ob ^ (((ob >> 9) & 1) << 5)); }
__host__ __device__ __forceinline__ void stage_rc(int b, int& R, int& C) { const int st = b / 1024, sb = b % 1024, swz = sb ^ (((sb >> 9) & 1) << 5); R = (st >> 1) * 16 + swz / 64; C = (st & 1) * 32 + (swz % 64) / 2; }
__host__ __device__ __forceinline__ int perm32(int rho) { const int n = rho >> 4, i = rho & 15; return 8 * (i >> 2) + 4 * n + (i & 3); }
struct Unit { int pm, pn, gid; };
__device__ __forceinline__ void order_map(int L, int nM, int nN, Unit& u) {
    const int nwg = nM * nN; int wgid = L; { const int q = nwg / NXCD, r = nwg % NXCD, xcd = wgid % NXCD, off = wgid / NXCD; wgid = (xcd < r ? xcd * (q + 1) : r * (q + 1) + (xcd - r) * q) + off; }
    const int nig = WGM * nN, gid = wgid / nig, fm = gid * WGM, gsz = (nM - fm) < WGM ? (nM - fm) : WGM;
    u.pm = fm + ((wgid % nig) % gsz); u.pn = (wgid % nig) / gsz;
}
struct Sched1 {
    const bf16_t* A; const bf16_t* Bt; int nM, nN, G, c;
    __device__ __forceinline__ bool next(int i, Unit& u) const { const long L = (long)i * G + c; if (c < 0 || L >= (long)nM * nN) return false; order_map((int)L, nM, nN, u); u.gid = 0; return true; }
    __device__ __forceinline__ const char* tileA(const Unit& u, size_t tstep) const { return (const char*)A + (size_t)u.pm * tstep; }
    __device__ __forceinline__ const char* tileB(const Unit& u, size_t tstep) const { return (const char*)Bt + (size_t)u.pn * tstep; }
    __device__ __forceinline__ void a_ready(const Unit&) const {}
    __device__ __forceinline__ void done(const Unit&) const {}
};
template <class Emit> struct EpiEmit {
    static constexpr bool PERM = true, AFTER_DRAIN = false; Emit E;
    __device__ __forceinline__ void operator()(const f32x4 (&acc)[2][2][4][2], const Unit& u, int wr, int wc, int fr, int fq) const {
#pragma unroll
        for (int ai = 0; ai < 2; ++ai)
#pragma unroll
            for (int m = 0; m < 4; ++m) {
                float a[8], b[8];
#pragma unroll
                for (int j = 0; j < 8; ++j) { a[j] = acc[ai][0][m][j >> 2][j & 3]; b[j] = acc[ai][1][m][j >> 2][j & 3]; }
                E(u.gid, u.pm * BM + ai * HALF + wr * 64 + m * 16 + fr, u.pn, wc * 32 + fq * 8, a, b);
            }
    }
};
template <class Epi, class Sched, bool ALIGN_EPI = false, bool SP2 = false>
__device__ __forceinline__ void gemm_phase(PG8_LAS unsigned char* lds, const int K, const Sched& S, const Epi& E) {
    const int tid = threadIdx.x, wid = __builtin_amdgcn_readfirstlane(tid >> 6), lane = tid & 63, wr = wid >> 2, wc = wid & 3, fr = lane & 15, fq = lane >> 4;
    const int nt = K / BK;
    unsigned voffA[2], voffB[2];
#pragma unroll
    for (int i = 0; i < 2; ++i) { int R, C; stage_rc(tid * 16 + i * 8192, R, C); const int Rb = Epi::PERM ? ((R & ~31) + perm32(R & 31)) : R;
        voffA[i] = (unsigned)(R * K + C) * 2u; voffB[i] = (unsigned)(Rb * K + C) * 2u; }
    const size_t kstep = (size_t)(BK * 2);
    const size_t hstep = (size_t)HALF * K * 2;
    const size_t tstep = 2 * hstep;
    const unsigned ldsw = (unsigned)wid * 1024u;
    const int aoff = lds_byte(wr * 64 + fr, fq * 8), boff = lds_byte(wc * 32 + fr, fq * 8);
#define PG8_SA(b, h) (((b) * 2 + (h)) * HTB)
#define PG8_SB(b, h) ((4 + (b) * 2 + (h)) * HTB)
#define PG8_STAGE(bufoff, gbase, voff) do { _Pragma("unroll") for (int _i = 0; _i < 2; ++_i) \
        __builtin_amdgcn_global_load_lds((const unsigned*)((const char*)(gbase) + (voff)[_i]), (PG8_LAS unsigned*)(lds + (bufoff) + ldsw + _i * 8192), 16, 0, 0); } while (0)
#define PG8_LDA(dst, b, h) do { _Pragma("unroll") for (int m = 0; m < 4; ++m) _Pragma("unroll") for (int k = 0; k < 2; ++k) dst[m][k] = *(const PG8_LAS bf16x8*)(lds + PG8_SA(b, h) + aoff + m * 2048 + k * 1024); } while (0)
#define PG8_LDB(dst, b, h) do { _Pragma("unroll") for (int n = 0; n < 2; ++n) _Pragma("unroll") for (int k = 0; k < 2; ++k) dst[n][k] = *(const PG8_LAS bf16x8*)(lds + PG8_SB(b, h) + boff + n * 2048 + k * 1024); } while (0)
#define PG8_MMA(ai, bj, At, Bt) do { __builtin_amdgcn_s_setprio(1); _Pragma("unroll") for (int m = 0; m < 4; ++m) _Pragma("unroll") for (int n = 0; n < 2; ++n) _Pragma("unroll") for (int k = 0; k < 2; ++k) \
        acc[ai][bj][m][n] = __builtin_amdgcn_mfma_f32_16x16x32_bf16(Bt[n][k], At[m][k], acc[ai][bj][m][n], 0, 0, 0); __builtin_amdgcn_s_setprio(0); } while (0)
#define PG8_WAIT_V(n) asm volatile("s_waitcnt vmcnt(" #n ")" ::: "memory")
#define PG8_WAIT_L(n) asm volatile("s_waitcnt lgkmcnt(" #n ")" ::: "memory")
#define PG8_BAR __builtin_amdgcn_s_barrier()
#define PG8_SCHED __builtin_amdgcn_sched_barrier(0)
    Unit cur, nxt; int ui = 0;
    if (!S.next(0, cur)) return;
    f32x4 acc[2][2][4][2];
#pragma unroll
    for (int a = 0; a < 2; ++a)
#pragma unroll
        for (int b = 0; b < 2; ++b)
#pragma unroll
            for (int m = 0; m < 4; ++m)
#pragma unroll
                for (int n = 0; n < 2; ++n) acc[a][b][m][n] = (f32x4){0.f, 0.f, 0.f, 0.f};
    bf16x8 At[4][2], B0[2][2], B1[2][2];
    const char* cA = S.tileA(cur, tstep); const char* cB = S.tileB(cur, tstep);
    S.a_ready(cur);
    if constexpr (SP2) {
        PG8_STAGE(PG8_SB(0, 0), cB, voffB); PG8_STAGE(PG8_SB(0, 1), cB + hstep, voffB); PG8_STAGE(PG8_SA(0, 0), cA, voffA); PG8_STAGE(PG8_SA(0, 1), cA + hstep, voffA);
        if (wr == 1) PG8_BAR;
        PG8_WAIT_V(2); PG8_BAR;
        PG8_STAGE(PG8_SB(1, 0), cB + kstep, voffB); PG8_STAGE(PG8_SA(1, 0), cA + kstep, voffA); PG8_STAGE(PG8_SB(1, 1), cB + hstep + kstep, voffB);
        PG8_WAIT_V(6); PG8_BAR;
    } else {
        PG8_STAGE(PG8_SB(0, 0), cB, voffB); PG8_STAGE(PG8_SA(0, 0), cA, voffA); PG8_STAGE(PG8_SB(0, 1), cB + hstep, voffB); PG8_STAGE(PG8_SA(0, 1), cA + hstep, voffA);
        if (wr == 1) PG8_BAR;
        PG8_WAIT_V(4); PG8_BAR;
        PG8_STAGE(PG8_SB(1, 0), cB + kstep, voffB); PG8_STAGE(PG8_SA(1, 0), cA + kstep, voffA); PG8_STAGE(PG8_SB(1, 1), cB + hstep + kstep, voffB);
        PG8_WAIT_V(6); PG8_BAR;
    }
    for (;;) {
        const bool has_next = S.next(ui + 1, nxt);
        const char* nA = has_next ? S.tileA(nxt, tstep) : cA; const char* nB = has_next ? S.tileB(nxt, tstep) : cB;
        for (int t = 0; t < nt; t += 2) {
            const bool last = (t == nt - 2);
            const char* a1 = cA + (size_t)(t + 1) * kstep;
            const char* a2 = last ? nA : cA + (size_t)(t + 2) * kstep; const char* b2 = last ? nB : cB + (size_t)(t + 2) * kstep;
            const char* a3 = a2 + kstep; const char* b3 = b2 + kstep;
            if (last && has_next) S.a_ready(nxt);
            if constexpr (SP2) {
            PG8_LDB(B0, 0, 0); PG8_LDB(B1, 0, 1); PG8_SCHED; PG8_LDA(At, 0, 0); PG8_STAGE(PG8_SA(1, 1), a1 + hstep, voffA);
            PG8_WAIT_V(8); PG8_WAIT_L(0); PG8_BAR; PG8_MMA(0, 0, At, B0); PG8_MMA(0, 1, At, B1); PG8_BAR; PG8_SCHED;
            PG8_LDA(At, 0, 1); PG8_STAGE(PG8_SB(0, 0), b2, voffB); PG8_STAGE(PG8_SB(0, 1), b2 + hstep, voffB); PG8_STAGE(PG8_SA(0, 0), a2, voffA);
            PG8_WAIT_V(8); PG8_WAIT_L(0); PG8_BAR; PG8_MMA(1, 0, At, B0); PG8_MMA(1, 1, At, B1); PG8_BAR; PG8_SCHED;
            PG8_LDB(B0, 1, 0); PG8_LDB(B1, 1, 1); PG8_SCHED; PG8_LDA(At, 1, 0); PG8_STAGE(PG8_SA(0, 1), a2 + hstep, voffA);
            PG8_WAIT_V(8); PG8_WAIT_L(0); PG8_BAR; PG8_MMA(0, 0, At, B0); PG8_MMA(0, 1, At, B1); PG8_BAR; PG8_SCHED;
            PG8_LDA(At, 1, 1); PG8_STAGE(PG8_SB(1, 0), b3, voffB); PG8_STAGE(PG8_SB(1, 1), b3 + hstep, voffB); PG8_STAGE(PG8_SA(1, 0), a3, voffA);
            PG8_WAIT_V(8); PG8_WAIT_L(0); PG8_BAR; PG8_MMA(1, 0, At, B0); PG8_MMA(1, 1, At, B1); PG8_BAR; PG8_SCHED;
            } else {
            PG8_LDB(B0, 0, 0); PG8_SCHED; PG8_LDA(At, 0, 0); PG8_STAGE(PG8_SA(1, 1), a1 + hstep, voffA);
            PG8_WAIT_L(8); PG8_BAR; PG8_WAIT_L(0); PG8_MMA(0, 0, At, B0); PG8_BAR; PG8_SCHED;
            PG8_LDB(B1, 0, 1); PG8_STAGE(PG8_SB(0, 0), b2, voffB);
            PG8_BAR; PG8_WAIT_L(0); PG8_MMA(0, 1, At, B1); PG8_BAR;
            PG8_LDA(At, 0, 1); PG8_STAGE(PG8_SA(0, 0), a2, voffA);
            PG8_BAR; PG8_WAIT_L(0); PG8_MMA(1, 0, At, B0); PG8_BAR; PG8_SCHED;
            PG8_STAGE(PG8_SB(0, 1), b2 + hstep, voffB);
            PG8_WAIT_V(6); PG8_BAR; PG8_MMA(1, 1, At, B1); PG8_BAR;
            PG8_LDB(B0, 1, 0); PG8_SCHED; PG8_LDA(At, 1, 0); PG8_STAGE(PG8_SA(0, 1), a2 + hstep, voffA);
            PG8_WAIT_L(8); PG8_BAR; PG8_WAIT_L(0); PG8_MMA(0, 0, At, B0); PG8_BAR; PG8_SCHED;
            PG8_LDB(B1, 1, 1); PG8_STAGE(PG8_SB(1, 0), b3, voffB);
            PG8_BAR; PG8_WAIT_L(0); PG8_MMA(0, 1, At, B1); PG8_BAR;
            PG8_LDA(At, 1, 1); PG8_STAGE(PG8_SA(1, 0), a3, voffA);
            PG8_BAR; PG8_WAIT_L(0); PG8_MMA(1, 0, At, B0); PG8_BAR; PG8_SCHED;
            PG8_STAGE(PG8_SB(1, 1), b3 + hstep, voffB);
            PG8_WAIT_V(6); PG8_BAR; PG8_MMA(1, 1, At, B1); PG8_BAR;
            }
        }
        if constexpr (ALIGN_EPI) { if (wr == 0) PG8_BAR; }
        if constexpr (!Epi::AFTER_DRAIN) { E(acc, cur, wr, wc, fr, fq); S.done(cur); }
        if (!has_next) break;
#pragma unroll
        for (int a = 0; a < 2; ++a)
#pragma unroll
            for (int b = 0; b < 2; ++b)
#pragma unroll
                for (int m = 0; m < 4; ++m)
#pragma unroll
                    for (int n = 0; n < 2; ++n) acc[a][b][m][n] = (f32x4){0.f, 0.f, 0.f, 0.f};
        cur = nxt; cA = nA; cB = nB; ++ui;
        if constexpr (ALIGN_EPI) { if (wr == 1) PG8_BAR; }
    }
    PG8_WAIT_V(0);
    if constexpr (!ALIGN_EPI) { if (wr == 0) PG8_BAR; }
    PG8_BAR;
    if constexpr (Epi::AFTER_DRAIN) { E.fused(acc, cur, wr, wc, fr, fq, lds, wid, lane); S.done(cur); }
#undef PG8_SA
#undef PG8_SB
#undef PG8_STAGE
#undef PG8_LDA
#undef PG8_LDB
#undef PG8_MMA
#undef PG8_WAIT_V
#undef PG8_WAIT_L
#undef PG8_BAR
#undef PG8_SCHED
}
}

template <class Emit>
__device__ __forceinline__ void naive_gemm(const Frame& F, const bf16* A, const bf16* Bt, int Mr, int N, int K, const Emit& E) {
    const long nitem = (long)Mr * (N / 256) * 16;
    for (long i = F.gtid; i < nitem; i += F.NT) {
        const int l = (int)(i & 63); const long g = i >> 6; const int rg = (int)(g % (Mr / 4)), pn = (int)(g / (Mr / 4));
        const int row = rg * 4 + (l >> 4), c8 = (l & 15) * 8;
        float a[8], b[8];
#pragma unroll
        for (int j = 0; j < 8; ++j) { a[j] = 0.f; b[j] = 0.f; }
        const bf16* ap = A + (size_t)row * K; const bf16* bp = Bt + (size_t)(256 * pn + c8) * K;
        for (int k = 0; k < K; k += 8) {
            float av[8]; unpack8(*(const v4u*)(ap + k), av);
#pragma unroll
            for (int j = 0; j < 8; ++j) {
                float bv[8]; unpack8(*(const v4u*)(bp + (size_t)j * K + k), bv);
                float cv[8]; unpack8(*(const v4u*)(bp + (size_t)(128 + j) * K + k), cv);
#pragma unroll
                for (int e = 0; e < 8; ++e) { a[j] += av[e] * bv[e]; b[j] += av[e] * cv[e]; }
            }
        }
        E(0, row, pn, c8, a, b);
    }
}

__device__ __forceinline__ void transpose_item(const float* W, int ldw, int col0, const float* g, bf16* WT, int Kd, int n0, int k0, LAS float* scr, int lane) {
#pragma unroll 8
    for (int i = 0; i < 32; ++i) { const int kk = 2 * i + (lane >> 5); const float gv = g ? g[k0 + kk] : 1.f; scr[kk * 33 + (lane & 31)] = W[(size_t)(k0 + kk) * ldw + col0 + (lane & 31)] * gv; }
    asm volatile("s_waitcnt lgkmcnt(0)" ::: "memory");
    const int c = lane & 7;
#pragma unroll
    for (int j = 0; j < 4; ++j) { const int n = (lane >> 3) + 8 * j; const LAS float* s = scr + (8 * c) * 33 + n;
        v4u o; o.x = pk2(s[0 * 33], s[1 * 33]); o.y = pk2(s[2 * 33], s[3 * 33]); o.z = pk2(s[4 * 33], s[5 * 33]); o.w = pk2(s[6 * 33], s[7 * 33]);
        *(v4u*)(WT + (size_t)(n0 + n) * Kd + k0 + 8 * c) = o; }
    asm volatile("s_waitcnt lgkmcnt(0)" ::: "memory");
}
__device__ __forceinline__ void norm_row_bf16(const float* xrow, const float* gain, bf16* orow, int lane) {
    const f32x4* xr = (const f32x4*)xrow + lane; f32x4 v[4]; float s = 0.f;
#pragma unroll
    for (int j = 0; j < 4; ++j) { v[j] = xr[64 * j]; s += (v[j].x * v[j].x + v[j].y * v[j].y) + (v[j].z * v[j].z + v[j].w * v[j].w); }
    const float r = 1.f / sqrtf(wave_sum(s) * (1.f / D) + EPS);
    v2u* o8 = (v2u*)orow + lane;
#pragma unroll
    for (int j = 0; j < 4; ++j) { f32x4 gg = gain ? ((const f32x4*)gain)[lane + 64 * j] : (f32x4){1.f, 1.f, 1.f, 1.f};
        v2u w; w.x = pk2(v[j].x * r * gg.x, v[j].y * r * gg.y); w.y = pk2(v[j].z * r * gg.z, v[j].w * r * gg.w); o8[64 * j] = w; }
}
__device__ __forceinline__ void p_prologue(const Frame& F) {
    LAS float* scr = (LAS float*)(F.lds + F.wave * 16384);
    unsigned char* ws = F.ws;
    constexpr int I_GU = 16 * (NGU / 32), I_D = (DFF / 64) * (D / 32), I_IN = 16 * (INC / 32), I_SQ = 16 * 32, I_KV = 16 * 64;
    constexpr int NITEMS = 2 * I_GU + 2 * I_D + I_IN + 3 * I_SQ + I_KV;
    for (int it = F.gw; it < NITEMS; it += F.NGW) {
        int r = it;
        if (r < 2 * I_GU) {
            const int which = r / I_GU; r -= which * I_GU; const int nb = r % (NGU / 32), kb = r / (NGU / 32), n0 = 32 * nb, t = n0 / 256, w = n0 % 256, half = w / 128, col = 128 * t + (w % 128);
            const float* W = F.in[(which ? 18 : 3) + half]; const float* g = F.in[which ? 17 : 2];
            transpose_item(W, DFF, col, g, (bf16*)(ws + (which ? WS_WGU2 : WS_WGU1)), D, n0, 64 * kb, scr, F.lane); continue; }
        r -= 2 * I_GU;
        if (r < 2 * I_D) { const int which = r / I_D; r -= which * I_D; const int nb = r % (D / 32), kb = r / (D / 32);
            transpose_item(F.in[which ? 20 : 5], D, 32 * nb, nullptr, (bf16*)(ws + (which ? WS_WD2 : WS_WD1)), DFF, 32 * nb, 64 * kb, scr, F.lane); continue; }
        r -= 2 * I_D;
        if (r < I_IN) { const int nb = r % (INC / 32), kb = r / (INC / 32), n0 = 32 * nb; int col = n0;
            if (n0 >= 2560) { const int t = (n0 - 2560) / 256, w = (n0 - 2560) % 256, half = w / 128; col = (half ? 3072 : 2560) + 128 * t + (w % 128); }
            transpose_item(F.in[7], INC, col, F.in[6], (bf16*)(ws + WS_WIN), D, n0, 64 * kb, scr, F.lane); continue; }
        r -= I_IN;
        if (r < 3 * I_SQ) { const int which = r / I_SQ; r -= which * I_SQ; const int nb = r % 32, kb = r / 32;
            const float* W = F.in[which == 0 ? 11 : (which == 1 ? 14 : 16)]; const float* g = which == 1 ? F.in[12] : nullptr;
            bf16* dst = (bf16*)(ws + (which == 0 ? WS_WOUT : (which == 1 ? WS_WQ : WS_WO)));
            transpose_item(W, D, 32 * nb, g, dst, D, 32 * nb, 64 * kb, scr, F.lane); continue; }
        r -= 3 * I_SQ;
        { const int nb = r % 64, kb = r / 64; transpose_item(F.in[15], 2 * D, 32 * nb, nullptr, (bf16*)(ws + WS_WKV), D, 32 * nb, 64 * kb, scr, F.lane); }
    }
    for (int m = F.gw; m < M; m += F.NGW) norm_row_bf16(F.in[0] + (size_t)m * D, nullptr, (bf16*)(ws + WS_XN) + (size_t)m * D, F.lane);
    for (int m = F.gw; m < MROWS; m += F.NGW) norm_row_bf16(F.in[1] + (size_t)m * D, F.in[13], (bf16*)(ws + WS_MN) + (size_t)m * D, F.lane);
    if (F.gtid < HF) { const float p0 = F.in[8][F.gtid], p1 = F.in[8][HF + F.gtid]; const float mx = fmaxf(p0, p1), e0 = __expf(p0 - mx), e1 = __expf(p1 - mx);
        ((float*)(ws + WS_LB))[F.gtid] = e0 / (e0 + e1); }
}

__device__ __forceinline__ void p_rowstat(const Frame& F) {
    float* RS = (float*)(F.ws + WS_RS);
    for (int m = F.gw; m < M; m += F.NGW) {
        const f32x4* xr = (const f32x4*)(F.out + (size_t)m * D) + F.lane; float s = 0.f;
#pragma unroll
        for (int j = 0; j < 4; ++j) { const f32x4 v = xr[64 * j]; s += (v.x * v.x + v.y * v.y) + (v.z * v.z + v.w * v.w); }
        s = wave_sum(s);
        if (F.lane == 0) RS[m] = 1.f / sqrtf(s * (1.f / D) + EPS);
    }
}
__device__ __forceinline__ void p_final(const Frame& F) {
    const float* g = F.in[21];
    for (int m = F.gw; m < M; m += F.NGW) {
        f32x4* xr = (f32x4*)(F.out + (size_t)m * D) + F.lane; f32x4 v[4]; float s = 0.f;
#pragma unroll
        for (int j = 0; j < 4; ++j) { v[j] = xr[64 * j]; s += (v[j].x * v[j].x + v[j].y * v[j].y) + (v[j].z * v[j].z + v[j].w * v[j].w); }
        const float r = 1.f / sqrtf(wave_sum(s) * (1.f / D) + EPS);
#pragma unroll
        for (int j = 0; j < 4; ++j) { const f32x4 gg = ((const f32x4*)g)[F.lane + 64 * j]; xr[64 * j] = (f32x4){v[j].x * r * gg.x, v[j].y * r * gg.y, v[j].z * r * gg.z, v[j].w * r * gg.w}; }
    }
}

__device__ __forceinline__ void p_conv(const Frame& F) {
    const bf16* ZB = (const bf16*)(F.ws + WS_ZB); const bf16* P = (const bf16*)(F.ws + WS_P); bf16* Y = (bf16*)(F.ws + WS_Y); const float* cw = F.in[10];
    const long nitem = (long)M * 64;
    for (long i = F.gtid; i < nitem; i += F.NT) {
        const int row = (int)(i >> 6), c8 = (int)(i & 63) * 8, t = row % SEQ;
        float zb[8], p0[8], p1[8], p2[8], o[8];
        unpack8(*(const v4u*)(ZB + (size_t)row * 512 + c8), zb);
        unpack8(*(const v4u*)(P + (size_t)row * 512 + c8), p2);
        if (t >= 1) unpack8(*(const v4u*)(P + (size_t)(row - 1) * 512 + c8), p1); else {
#pragma unroll
            for (int j = 0; j < 8; ++j) p1[j] = 0.f; }
        if (t >= 2) unpack8(*(const v4u*)(P + (size_t)(row - 2) * 512 + c8), p0); else {
#pragma unroll
            for (int j = 0; j < 8; ++j) p0[j] = 0.f; }
#pragma unroll
        for (int j = 0; j < 8; ++j) { const float* w = cw + (c8 + j) * 3; o[j] = zb[j] * (w[0] * p0[j] + w[1] * p1[j] + w[2] * p2[j]); }
        *(v4u*)(Y + (size_t)row * D + 512 + c8) = pack8(o);
    }
}

__device__ __forceinline__ void p_scan_simple(const Frame& F) {
    const bf16* Q = (const bf16*)(F.ws + WS_Q); const bf16* KK = (const bf16*)(F.ws + WS_KK); const bf16* V = (const bf16*)(F.ws + WS_V); const float* LOGF = (const float*)(F.ws + WS_LOGF);
    float* O32 = (float*)(F.ws + WS_DS);
    if (F.gtid < BATCH * NH * DV) {
    const int dv = (int)(F.gtid % DV), h = (int)(F.gtid / DV) % NH, b = (int)(F.gtid / (DV * NH));
    float S[DK];
#pragma unroll
    for (int i = 0; i < DK; ++i) S[i] = 0.f;
    for (int t = 0; t < SEQ; ++t) {
        const size_t tok = (size_t)b * SEQ + t;
        const float v = bf2f(V[(size_t)(h * 128 + dv) * M + tok]); float o = 0.f;
        const float* lp = LOGF + (size_t)(h * 128) * M + tok; const bf16* kp = KK + (size_t)(h * 128) * M + tok; const bf16* qp = Q + (size_t)(h * 128) * M + tok;
#pragma unroll
        for (int i = 0; i < DK; ++i) {
            const float f = __expf(*lp); S[i] = f * S[i] + bf2f(*kp) * v; o += S[i] * bf2f(*qp);
            lp += M; kp += M; qp += M; asm volatile("" : "+v"(lp), "+v"(kp), "+v"(qp));
        }
        O32[((size_t)b * SEQ + t) * 512 + h * 128 + dv] = o;
    }
    }
}
__device__ __forceinline__ void p_hnorm_simple(const Frame& F) {
    const float* O32 = (const float*)(F.ws + WS_DS); const bf16* SG = (const bf16*)(F.ws + WS_SG); bf16* Y = (bf16*)(F.ws + WS_Y); const float* g = F.in[9];
    for (int it = F.gw; it < M * NH; it += F.NGW) {
        const int row = it >> 2, h = it & 3; const size_t off = (size_t)row * 512 + h * 128 + 2 * F.lane;
        const float o0 = O32[off], o1 = O32[off + 1];
        const float r = 1.f / sqrtf(wave_sum(o0 * o0 + o1 * o1) * (1.f / DV) + EPS);
        const unsigned sg = *(const unsigned*)(SG + off);
        *(unsigned*)(Y + (size_t)row * D + h * 128 + 2 * F.lane) = pk2(o0 * r * g[h * 128 + 2 * F.lane] * bflo(sg), o1 * r * g[h * 128 + 2 * F.lane + 1] * bfhi(sg));
    }
}


typedef short bf16x8 __attribute__((ext_vector_type(8)));
typedef short bf16x4 __attribute__((ext_vector_type(4)));
#define MFMA16(a, b, c) __builtin_amdgcn_mfma_f32_16x16x32_bf16((a), (b), (c), 0, 0, 0)
__device__ __forceinline__ v2u pk4(f32x4 v) { v2u w; w.x = pk2(v[0], v[1]); w.y = pk2(v[2], v[3]); return w; }

struct ChunkRegs { f32x4 lf[4]; v4u kw[2]; v4u qw[2]; v4u vw[2]; };
template <bool WITH_Q>
__device__ __forceinline__ void chunk_load(ChunkRegs& R, const unsigned char* ws, int u, int dk, int sq) {
    const int c = u & 63, h = (u >> 6) & 3, b = u >> 8;
    const size_t roff = (size_t)(h * 128 + dk) * M + (size_t)b * SEQ + c * 64 + sq * 16;
    const float* LOGFT = (const float*)(ws + WS_LOGF) + roff; const bf16* KT = (const bf16*)(ws + WS_KK) + roff; const bf16* VT = (const bf16*)(ws + WS_V) + roff; const bf16* QT = (const bf16*)(ws + WS_Q) + roff;
#pragma unroll
    for (int i = 0; i < 4; ++i) R.lf[i] = *(const f32x4*)(LOGFT + 4 * i);
#pragma unroll
    for (int i = 0; i < 2; ++i) { R.kw[i] = *(const v4u*)(KT + 8 * i); R.vw[i] = *(const v4u*)(VT + 8 * i); if (WITH_Q) R.qw[i] = *(const v4u*)(QT + 8 * i); }
}
__device__ __forceinline__ float chunk_cumsum(const ChunkRegs& R, int lane, int sq, float (&bt)[16]) {
    float run = 0.f;
#pragma unroll
    for (int i = 0; i < 16; ++i) { run += R.lf[i >> 2][i & 3]; bt[i] = run; }
    const int base = lane & ~3;
    const float t0 = __shfl(run, base), t1 = __shfl(run, base + 1), t2 = __shfl(run, base + 2), t3 = __shfl(run, base + 3);
    const float pre = (sq > 0 ? t0 : 0.f) + (sq > 1 ? t1 : 0.f) + (sq > 2 ? t2 : 0.f);
#pragma unroll
    for (int i = 0; i < 16; ++i) bt[i] += pre;
    return (t0 + t1) + (t2 + t3);
}
constexpr int NUNIT = BATCH * NH * NCHUNK;
__device__ __forceinline__ void p_scanA(const Frame& F) {
    unsigned char* ws = F.ws; bf16* DS = (bf16*)(ws + WS_DS); float* DEC = (float*)(ws + WS_DEC);
    LAS unsigned char* KhT = F.lds; LAS unsigned char* VTl = F.lds + 18432;
    const int tid = F.tid, lane = F.lane, w = F.wave, dk = tid >> 2, sq = tid & 3, i16 = lane & 15, q4 = lane >> 4;
    ChunkRegs R;
    int u = F.vcu; if (u < NUNIT) chunk_load<false>(R, ws, u, dk, sq);
    for (; u < NUNIT; u += F.G) {
        float bt[16]; const float tot = chunk_cumsum(R, lane, sq, bt);
        float kf[16]; { float t8[8]; unpack8(R.kw[0], t8);
#pragma unroll
            for (int j = 0; j < 8; ++j) kf[j] = t8[j]; unpack8(R.kw[1], t8);
#pragma unroll
            for (int j = 0; j < 8; ++j) kf[8 + j] = t8[j]; }
        float o0[8], o1[8];
#pragma unroll
        for (int j = 0; j < 8; ++j) { o0[j] = kf[j] * __expf(tot - bt[j]); o1[j] = kf[8 + j] * __expf(tot - bt[8 + j]); }
        *(LAS v4u*)(KhT + dk * 144 + sq * 32) = pack8(o0); *(LAS v4u*)(KhT + dk * 144 + sq * 32 + 16) = pack8(o1);
        *(LAS v4u*)(VTl + dk * 144 + sq * 32) = R.vw[0]; *(LAS v4u*)(VTl + dk * 144 + sq * 32 + 16) = R.vw[1];
        if (sq == 0) DEC[(size_t)u * 128 + dk] = __expf(tot);
        __syncthreads();
        if (u + F.G < NUNIT) chunk_load<false>(R, ws, u + F.G, dk, sq);
        const bf16x8 a0 = *(const LAS bf16x8*)(KhT + (16 * w + i16) * 144 + q4 * 16), a1 = *(const LAS bf16x8*)(KhT + (16 * w + i16) * 144 + 64 + q4 * 16);
#pragma unroll
        for (int dvb = 0; dvb < 8; ++dvb) {
            const bf16x8 b0 = *(const LAS bf16x8*)(VTl + (16 * dvb + i16) * 144 + q4 * 16), b1 = *(const LAS bf16x8*)(VTl + (16 * dvb + i16) * 144 + 64 + q4 * 16);
            f32x4 acc = (f32x4){0.f, 0.f, 0.f, 0.f};
            acc = MFMA16(a0, b0, acc); acc = MFMA16(a1, b1, acc);
            *(v2u*)(DS + (size_t)u * 16384 + (16 * dvb + i16) * 128 + 16 * w + 4 * q4) = pk4(acc);
        }
        __syncthreads();
    }
}
__device__ __forceinline__ void p_scanB(const Frame& F) {
    unsigned* DSu = (unsigned*)(F.ws + WS_DS); const float* DEC = (const float*)(F.ws + WS_DEC);
    for (long e = F.gtid; e < (long)BATCH * NH * 8192; e += F.NT) {
        const int bh = (int)(e >> 13), pr = (int)(e & 8191), dk = (2 * pr) & 127;
        unsigned* p = DSu + (size_t)bh * 64 * 8192 + pr; const float* dec = DEC + (size_t)bh * 64 * 128 + dk;
        float S0 = 0.f, S1 = 0.f;
        for (int c0 = 0; c0 < NCHUNK; c0 += 16) {
            unsigned wv[16]; float d0[16], d1[16];
#pragma unroll
            for (int j = 0; j < 16; ++j) { wv[j] = p[(size_t)(c0 + j) * 8192]; d0[j] = dec[(c0 + j) * 128]; d1[j] = dec[(c0 + j) * 128 + 1]; }
#pragma unroll
            for (int j = 0; j < 16; ++j) { p[(size_t)(c0 + j) * 8192] = pk2(S0, S1); S0 = d0[j] * S0 + bflo(wv[j]); S1 = d1[j] * S1 + bfhi(wv[j]); }
        }
    }
}
constexpr int LC_QS = 0, LC_KS = 17408, LC_VT = 34816, LC_P = 53248, LC_ST = 62464, LC_RED = 97280;
__device__ __forceinline__ void p_scanC(const Frame& F) {
    unsigned char* ws = F.ws; const bf16* DS = (const bf16*)(ws + WS_DS); const bf16* SG = (const bf16*)(ws + WS_SG); bf16* Y = (bf16*)(ws + WS_Y); const float* gh = F.in[9];
    LAS unsigned char* L = F.lds;
    const int tid = F.tid, lane = F.lane, w = F.wave, dk = tid >> 2, sq = tid & 3, i16 = lane & 15, q4 = lane >> 4;
    ChunkRegs R; v4u st[4];
    int u = F.vcu;
    if (u < NUNIT) { chunk_load<true>(R, ws, u, dk, sq);
#pragma unroll
        for (int i = 0; i < 4; ++i) { const int p = tid + 512 * i; st[i] = *(const v4u*)(DS + (size_t)u * 16384 + (p >> 4) * 128 + (p & 15) * 8); } }
    for (; u < NUNIT; u += F.G) {
        const int c = u & 63, h = (u >> 6) & 3, b = u >> 8;
        float bt[16]; (void)chunk_cumsum(R, lane, sq, bt);
        { float kf[8], qf[8];
#pragma unroll
          for (int hh = 0; hh < 2; ++hh) { unpack8(R.kw[hh], kf); unpack8(R.qw[hh], qf);
#pragma unroll
            for (int j = 0; j < 8; ++j) { const int t = 16 * sq + 8 * hh + j; const float e = __expf(bt[8 * hh + j]);
                const int off = t * 272 + ((dk >> 3) ^ (2 * sq)) * 16 + (dk & 7) * 2;
                *(LAS bf16*)(L + LC_QS + off) = (bf16)f2bf(qf[j] * e); *(LAS bf16*)(L + LC_KS + off) = (bf16)f2bf(kf[j] / e); } } }
        *(LAS v4u*)(L + LC_VT + dk * 144 + sq * 32) = R.vw[0]; *(LAS v4u*)(L + LC_VT + dk * 144 + sq * 32 + 16) = R.vw[1];
#pragma unroll
        for (int i = 0; i < 4; ++i) { const int p = tid + 512 * i; *(LAS v4u*)(L + LC_ST + (p >> 4) * 272 + (p & 15) * 16) = st[i]; }
        __syncthreads();
        if (u + F.G < NUNIT) { chunk_load<true>(R, ws, u + F.G, dk, sq);
#pragma unroll
            for (int i = 0; i < 4; ++i) { const int p = tid + 512 * i; st[i] = *(const v4u*)(DS + (size_t)(u + F.G) * 16384 + (p >> 4) * 128 + (p & 15) * 8); } }
        const int row0 = b * SEQ + c * 64, col = h * 128 + 16 * w + 4 * q4;
        v2u sgw[4];
#pragma unroll
        for (int tb = 0; tb < 4; ++tb) sgw[tb] = *(const v2u*)(SG + (size_t)(row0 + 16 * tb + i16) * 512 + col);
        { const int tb = w & 3, sb0 = 2 * (w >> 2);
          f32x4 a0 = (f32x4){0.f, 0.f, 0.f, 0.f}, a1 = a0;
#pragma unroll
          for (int ks = 0; ks < 4; ++ks) {
              const bf16x8 qb = *(const LAS bf16x8*)(L + LC_QS + (16 * tb + i16) * 272 + (((4 * ks + q4) ^ (2 * tb)) * 16));
              const bf16x8 k0 = *(const LAS bf16x8*)(L + LC_KS + (16 * sb0 + i16) * 272 + (((4 * ks + q4) ^ (2 * sb0)) * 16));
              const bf16x8 k1 = *(const LAS bf16x8*)(L + LC_KS + (16 * (sb0 + 1) + i16) * 272 + (((4 * ks + q4) ^ (2 * (sb0 + 1))) * 16));
              a0 = MFMA16(k0, qb, a0); a1 = MFMA16(k1, qb, a1); }
          const int t = 16 * tb + i16;
#pragma unroll
          for (int r = 0; r < 4; ++r) { if (16 * sb0 + 4 * q4 + r > t) a0[r] = 0.f; if (16 * (sb0 + 1) + 4 * q4 + r > t) a1[r] = 0.f; }
          *(LAS v2u*)(L + LC_P + t * 144 + (16 * sb0 + 4 * q4) * 2) = pk4(a0); *(LAS v2u*)(L + LC_P + t * 144 + (16 * (sb0 + 1) + 4 * q4) * 2) = pk4(a1); }
        __syncthreads();
        f32x4 o[4];
        { bf16x8 av[2], as[4];
#pragma unroll
          for (int ks = 0; ks < 2; ++ks) av[ks] = *(const LAS bf16x8*)(L + LC_VT + (16 * w + i16) * 144 + ks * 64 + q4 * 16);
#pragma unroll
          for (int ks = 0; ks < 4; ++ks) as[ks] = *(const LAS bf16x8*)(L + LC_ST + (16 * w + i16) * 272 + (4 * ks + q4) * 16);
#pragma unroll
          for (int tb = 0; tb < 4; ++tb) {
              f32x4 acc = (f32x4){0.f, 0.f, 0.f, 0.f};
#pragma unroll
              for (int ks = 0; ks < 2; ++ks) if (ks == 0 || tb >= 2) acc = MFMA16(av[ks], *(const LAS bf16x8*)(L + LC_P + (16 * tb + i16) * 144 + ks * 64 + q4 * 16), acc);
#pragma unroll
              for (int ks = 0; ks < 4; ++ks) acc = MFMA16(as[ks], *(const LAS bf16x8*)(L + LC_QS + (16 * tb + i16) * 272 + (((4 * ks + q4) ^ (2 * tb)) * 16)), acc);
              o[tb] = acc;
              float ss = (acc[0] * acc[0] + acc[1] * acc[1]) + (acc[2] * acc[2] + acc[3] * acc[3]);
              ss += __shfl_xor(ss, 16); ss += __shfl_xor(ss, 32);
              if (q4 == 0) *(LAS float*)(L + LC_RED + (w * 64 + 16 * tb + i16) * 4) = ss;
          } }
        __syncthreads();
        const f32x4 gv = *(const f32x4*)(gh + col);
#pragma unroll
        for (int tb = 0; tb < 4; ++tb) {
            float tot = 0.f;
#pragma unroll
            for (int ww = 0; ww < 8; ++ww) tot += *(const LAS float*)(L + LC_RED + (ww * 64 + 16 * tb + i16) * 4);
            const float rr = 1.f / sqrtf(tot * (1.f / DV) + EPS);
            v2u yo; yo.x = pk2(o[tb][0] * rr * gv[0] * bflo(sgw[tb].x), o[tb][1] * rr * gv[1] * bfhi(sgw[tb].x)); yo.y = pk2(o[tb][2] * rr * gv[2] * bflo(sgw[tb].y), o[tb][3] * rr * gv[3] * bfhi(sgw[tb].y));
            *(v2u*)(Y + (size_t)(row0 + 16 * tb + i16) * D + col) = yo;
        }
        __syncthreads();
    }
}

__device__ __forceinline__ void p_attn_simple(const Frame& F) {
    const bf16* QM = (const bf16*)(F.ws + WS_QM); const bf16* KM = (const bf16*)(F.ws + WS_KM); const bf16* VMT = (const bf16*)(F.ws + WS_VMT); bf16* ATT = (bf16*)(F.ws + WS_ATT);
    const int lane = F.lane;
    for (int it = F.gw; it < M * MH; it += F.NGW) {
        const int row = it >> 2, h = it & 3, b = row / SEQ;
        const v2u qw = *(const v2u*)(QM + (size_t)row * D + h * MHD + 4 * lane);
        const float q0 = bflo(qw.x), q1 = bfhi(qw.x), q2 = bflo(qw.y), q3 = bfhi(qw.y);
        float sc[4];
#pragma unroll
        for (int jj = 0; jj < 4; ++jj) {
            float mine = 0.f;
            for (int jl = 0; jl < 64; ++jl) {
                const v2u kw = *(const v2u*)(KM + (size_t)(b * MEML + jj * 64 + jl) * D + h * MHD + 4 * lane);
                const float s = wave_sum(q0 * bflo(kw.x) + q1 * bfhi(kw.x) + q2 * bflo(kw.y) + q3 * bfhi(kw.y));
                if (lane == jl) mine = s;
            }
            sc[jj] = mine;
        }
        const float mx = wave_max(fmaxf(fmaxf(sc[0], sc[1]), fmaxf(sc[2], sc[3])));
        float l = 0.f;
#pragma unroll
        for (int jj = 0; jj < 4; ++jj) { sc[jj] = __expf(sc[jj] - mx); l += sc[jj]; }
        const float inv = 1.f / wave_sum(l);
        float acc[4] = {0.f, 0.f, 0.f, 0.f};
#pragma unroll
        for (int jj = 0; jj < 4; ++jj)
            for (int jc = 0; jc < 8; ++jc) {
                float p[8];
#pragma unroll
                for (int e = 0; e < 8; ++e) p[e] = __shfl(sc[jj], jc * 8 + e);
#pragma unroll
                for (int i = 0; i < 4; ++i) { float vv[8]; unpack8(*(const v4u*)(VMT + (size_t)(h * MHD + 4 * lane + i) * MROWS + b * MEML + jj * 64 + jc * 8), vv);
#pragma unroll
                    for (int e = 0; e < 8; ++e) acc[i] += p[e] * vv[e]; }
            }
        v2u o; o.x = pk2(acc[0] * inv, acc[1] * inv); o.y = pk2(acc[2] * inv, acc[3] * inv);
        *(v2u*)(ATT + (size_t)row * D + h * MHD + 4 * lane) = o;
    }
}


#ifndef OPT_SCAN
#define OPT_SCAN 1
#endif
#ifndef OPT_MASK
#define OPT_MASK 255
#endif
#define GEMM1(bit, multi, Ap, Bp, Mr, Nn, Kk, EmT, emv) GEMM1C(bit, multi, (int)blockIdx.x, Ap, Bp, Mr, Nn, Kk, EmT, emv)
#define GEMM1C(bit, multi, cc, Ap, Bp, Mr, Nn, Kk, EmT, emv) do { if constexpr ((OPT_MASK & (bit)) != 0) { \
        pg8::Sched1 S_{(Ap), (Bp), (Mr) / 256, (Nn) / 256, F.G, (cc)}; pg8::EpiEmit<EmT> E_{emv}; \
        pg8::gemm_phase<pg8::EpiEmit<EmT>, pg8::Sched1, multi, true>(F.lds, (Kk), S_, E_); \
    } else { naive_gemm(F, (Ap), (Bp), (Mr), (Nn), (Kk), emv); } } while (0)

struct Args { const float* in[22]; float* out; unsigned char* ws; int ph_lo, ph_hi; };
__global__ void __launch_bounds__(NTHR, 2) fwd(Args args) {
    extern __shared__ __attribute__((aligned(16))) unsigned char lds[];
    Frame F;
    F.lds = (LAS unsigned char*)lds;
    F.tid = threadIdx.x; F.lane = F.tid & 63; F.wave = __builtin_amdgcn_readfirstlane(F.tid >> 6);
    F.G = gridDim.x; { const int bx = blockIdx.x; F.vcu = (F.G % 8 == 0) ? (bx % 8) * (F.G / 8) + bx / 8 : bx; }
    F.gtid = (long)F.vcu * NTHR + F.tid; F.NT = (long)F.G * NTHR; F.gw = F.vcu * NWAVES + F.wave; F.NGW = F.G * NWAVES;
    F.in = args.in;
    F.out = args.out; F.ws = args.ws;
    unsigned char* ws = args.ws;
    const int lo = args.ph_lo, hi = args.ph_hi;
    for (int u = F.tid; u < (LDS_BYTES - LDSCTL_OFF) / 4; u += NTHR) ((LAS unsigned*)(F.lds + LDSCTL_OFF))[u] = 0u;
    __syncthreads();
    XcdBarrier bar; bar.bar = (unsigned*)(ws + WS_CTL) + CW_BAR; bar.x = 0; bar.st = nullptr;
    if (hi - lo > 1) bar = xcd_barrier_post((unsigned*)(ws + WS_CTL) + CW_BAR, (volatile LAS unsigned*)(F.lds + MISC_OFF) + 8);
#define IN(k) (lo <= (k) && (k) < hi)
#define SEAM(k) do { if (IN(k) && IN((k) + 1)) xcd_barrier(bar); } while (0)
    const float* RS = (const float*)(ws + WS_RS);
    if (IN(0)) p_prologue(F);
    SEAM(0);
    if (IN(1)) {
        GEMM1(1, true, (const bf16*)(ws + WS_XN), (const bf16*)(ws + WS_WGU1), M, NGU, D, EmGU, (EmGU{(bf16*)(ws + WS_HID), nullptr}));
        GEMM1C(1, false, (int)blockIdx.x - 128, (const bf16*)(ws + WS_MN), (const bf16*)(ws + WS_WKV), MROWS, D, D, EmPlain, (EmPlain{(bf16*)(ws + WS_KM), nullptr, 1.f}));
        GEMM1C(1, false, (int)blockIdx.x - 144, (const bf16*)(ws + WS_WKV) + (size_t)D * D, (const bf16*)(ws + WS_MN), D, MROWS, D, EmPlain, (EmPlain{(bf16*)(ws + WS_VMT), nullptr, 1.f}));
    }
    SEAM(1);
    if (IN(2)) GEMM1(2, false, (const bf16*)(ws + WS_HID), (const bf16*)(ws + WS_WD1), M, D, DFF, EmRes, (EmRes{F.in[0], F.out, (bf16*)(ws + WS_XB), 0.5f}));
    SEAM(2);
    if (IN(3)) p_rowstat(F);
    SEAM(3);
    if (IN(4)) {
        GEMM1(4, true, (const bf16*)(ws + WS_XB), (const bf16*)(ws + WS_WIN) + (size_t)1536 * D, M, 2048, D, EmInA, (EmInA{(bf16*)(ws + WS_SG), (bf16*)(ws + WS_ZB), (bf16*)(ws + WS_P), RS}));
        GEMM1(4, true, (const bf16*)(ws + WS_WIN), (const bf16*)(ws + WS_XB), 1536, M, D, EmInB,
              (EmInB{(bf16*)(ws + WS_Q), (bf16*)(ws + WS_KK), (bf16*)(ws + WS_V), (float*)(ws + WS_LOGF), RS, (const float*)(ws + WS_LB)}));
    }
    SEAM(4);
#if OPT_SCAN
    if (IN(5)) { p_conv(F); p_scanA(F); }
    SEAM(5);
    if (IN(6)) p_scanB(F);
    SEAM(6);
    if (IN(7)) p_scanC(F);
#else
    if (IN(5)) { p_conv(F); p_scan_simple(F); }
    SEAM(5);
    if (IN(6)) {}
    SEAM(6);
    if (IN(7)) p_hnorm_simple(F);
#endif
    SEAM(7);
    if (IN(8)) GEMM1(8, false, (const bf16*)(ws + WS_Y), (const bf16*)(ws + WS_WOUT), M, D, D, EmRes, (EmRes{F.out, F.out, (bf16*)(ws + WS_XB2), 1.f}));
    SEAM(8);
    if (IN(9)) p_rowstat(F);
    SEAM(9);
    if (IN(10)) GEMM1(16, false, (const bf16*)(ws + WS_XB2), (const bf16*)(ws + WS_WQ), M, D, D, EmPlain, (EmPlain{(bf16*)(ws + WS_QM), RS, 0.0625f}));
    SEAM(10);
    if (IN(11)) p_attn_simple(F);
    SEAM(11);
    if (IN(12)) GEMM1(32, false, (const bf16*)(ws + WS_ATT), (const bf16*)(ws + WS_WO), M, D, D, EmRes, (EmRes{F.out, F.out, (bf16*)(ws + WS_XB2), 1.f}));
    SEAM(12);
    if (IN(13)) p_rowstat(F);
    SEAM(13);
    if (IN(14)) GEMM1(64, true, (const bf16*)(ws + WS_XB2), (const bf16*)(ws + WS_WGU2), M, NGU, D, EmGU, (EmGU{(bf16*)(ws + WS_HID), RS}));
    SEAM(14);
    if (IN(15)) GEMM1(128, false, (const bf16*)(ws + WS_HID), (const bf16*)(ws + WS_WD2), M, D, DFF, EmRes, (EmRes{F.out, F.out, nullptr, 0.5f}));
    SEAM(15);
    if (IN(16)) p_final(F);
#undef IN
#undef SEAM
}

extern "C" void kernel_launch(void* const* d_in, const int* in_sizes, int n_in, void* d_out, int out_size, void* d_ws, size_t ws_size, hipStream_t stream) {
    static int grid = 0;
    if (grid == 0) {
        if (n_in != 22 || in_sizes[0] != M * D || out_size != M * D || ws_size < WS_END) { fprintf(stderr, "kernel_launch: unexpected shapes (n_in %d, in0 %d, out %d, ws %zu)\n", n_in, n_in > 0 ? in_sizes[0] : -1, out_size, ws_size); grid = -1; return; }
        int dev = 0, cus = 0;
        if (hipGetDevice(&dev) != hipSuccess || hipDeviceGetAttribute(&cus, hipDeviceAttributeMultiprocessorCount, dev) != hipSuccess) { grid = -1; return; }
        if (hipFuncSetAttribute((const void*)fwd, hipFuncAttributeMaxDynamicSharedMemorySize, LDS_BYTES) != hipSuccess) { fprintf(stderr, "kernel_launch: hipFuncSetAttribute failed\n"); grid = -1; return; }
        grid = cus;
    }
    if (grid < 0) return;
    Args a{};
    for (int i = 0; i < 22; ++i) a.in[i] = (const float*)d_in[i];
    a.out = (float*)d_out; a.ws = (unsigned char*)d_ws;
    if (hipMemsetAsync((char*)d_ws + WS_CTL, 0, CTL_ZERO_BYTES, stream) != hipSuccess) { fprintf(stderr, "kernel_launch: memset failed\n"); return; }
    a.ph_lo = 0; a.ph_hi = NPHASE;
    void* kargs[] = {&a};
    hipError_t e = hipLaunchCooperativeKernel((const void*)fwd, dim3(grid), dim3(NTHR), kargs, LDS_BYTES, stream);
    if (e != hipSuccess) fprintf(stderr, "kernel_launch: cooperative launch failed: %s (grid %d)\n", hipGetErrorString(e), grid);
}
```

```cpp
#include <hip/hip_runtime.h>
#include <cstdio>
#include <cstdint>

#define GAS __attribute__((address_space(1)))
#define LAS __attribute__((address_space(3)))
typedef unsigned short bf16;
typedef unsigned v4u __attribute__((ext_vector_type(4)));
typedef unsigned v2u __attribute__((ext_vector_type(2)));
typedef float f32x4 __attribute__((ext_vector_type(4)));

constexpr int BATCH = 4, SEQ = 4096, D = 1024, M = BATCH * SEQ, DFF = 2816, NGU = 2 * DFF, INC = 3584;
constexpr int HF = 512, NH = 4, DK = 128, DV = 128, CHUNK = 64, NCHUNK = SEQ / CHUNK;
constexpr int MEML = 256, MH = 4, MHD = 256, MROWS = BATCH * MEML;
constexpr float EPS = 1e-6f;
constexpr int NWAVES = 8, NTHR = NWAVES * 64;
constexpr int NPHASE = 17;

constexpr size_t MiB = 1u << 20;
constexpr size_t WS_CTL = 0, CTL_ZERO_BYTES = 1 * MiB;
constexpr size_t WS_LB = 1 * MiB, WS_RS = 1 * MiB + 65536;
constexpr size_t WS_WGU1 = 2 * MiB, WS_WD1 = 13 * MiB, WS_WIN = WS_WD1 + 5 * MiB + 512 * 1024, WS_WOUT = WS_WIN + 7 * MiB, WS_WQ = WS_WOUT + 2 * MiB,
                 WS_WKV = WS_WQ + 2 * MiB, WS_WO = WS_WKV + 4 * MiB, WS_WGU2 = WS_WO + 2 * MiB, WS_WD2 = WS_WGU2 + 11 * MiB, WS_MN = 52 * MiB, WS_KM = 54 * MiB, WS_VMT = 56 * MiB,
                 WS_DEC = 58 * MiB;
static_assert(WS_WD2 + 5 * MiB + 512 * 1024 == WS_MN, "weight map");
constexpr size_t WS_XN = 64 * MiB, WS_HID = 96 * MiB, WS_XB = 216 * MiB;
constexpr size_t WS_Q = 64 * MiB, WS_KK = 80 * MiB, WS_LOGF = 96 * MiB, WS_V = 128 * MiB, WS_SG = 144 * MiB, WS_ZB = 160 * MiB, WS_P = 176 * MiB, WS_DS = 192 * MiB, WS_Y = 224 * MiB;
constexpr size_t WS_XB2 = 64 * MiB, WS_QM = 96 * MiB, WS_ATT = 128 * MiB, WS_END = 256 * MiB;

constexpr int RING_BYTES = 131072, LDSCTL_OFF = RING_BYTES, MISC_OFF = LDSCTL_OFF + 320, LDS_BYTES = 147456;

__device__ __forceinline__ unsigned f2bf(float f) { unsigned u = __builtin_bit_cast(unsigned, f); return (u + 0x7fffu + ((u >> 16) & 1u)) >> 16; }
__device__ __forceinline__ unsigned pk2(float lo, float hi) { return f2bf(lo) | (f2bf(hi) << 16); }
__device__ __forceinline__ float bflo(unsigned w) { return __builtin_bit_cast(float, w << 16); }
__device__ __forceinline__ float bfhi(unsigned w) { return __builtin_bit_cast(float, w & 0xffff0000u); }
__device__ __forceinline__ float bf2f(bf16 b) { return __builtin_bit_cast(float, (unsigned)b << 16); }
__device__ __forceinline__ float wave_sum(float v) {
#pragma unroll
    for (int o = 1; o < 64; o <<= 1) v += __shfl_xor(v, o);
    return v;
}
__device__ __forceinline__ float wave_max(float v) {
#pragma unroll
    for (int o = 1; o < 64; o <<= 1) v = fmaxf(v, __shfl_xor(v, o));
    return v;
}
__device__ __forceinline__ float silu_f(float x) { return x / (1.f + __expf(-x)); }
__device__ __forceinline__ float sigm_f(float x) { return 1.f / (1.f + __expf(-x)); }
__device__ __forceinline__ void unpack8(v4u w, float (&f)[8]) {
    f[0] = bflo(w.x); f[1] = bfhi(w.x); f[2] = bflo(w.y); f[3] = bfhi(w.y); f[4] = bflo(w.z); f[5] = bfhi(w.z); f[6] = bflo(w.w); f[7] = bfhi(w.w);
}
__device__ __forceinline__ v4u pack8(const float (&f)[8]) { v4u w; w.x = pk2(f[0], f[1]); w.y = pk2(f[2], f[3]); w.z = pk2(f[4], f[5]); w.w = pk2(f[6], f[7]); return w; }


typedef GAS unsigned gu32;
constexpr int CW_TMO = 0, CW_CODE = 1, CW_BAR = 4096;
#define XB_TMO      128
#define XB_XCNT(j)  (256  + 64 * (j))
#define XB_XSUB(j)  (1280 + 64 * (j))
#define XB_XGEN(j)  (2304 + 64 * (j))
#define XB_TOP      3328
#define XB_TOPGEN   3392
#define XCD_BAR_WORDS 3456
#define XB_SPIN_CAP (1u << 18)
__device__ __forceinline__ unsigned xb_ld(unsigned* p)              { return __hip_atomic_load(p, __ATOMIC_RELAXED, __HIP_MEMORY_SCOPE_AGENT); }
__device__ __forceinline__ unsigned xb_add(unsigned* p, unsigned v) { return __hip_atomic_fetch_add(p, v, __ATOMIC_RELAXED, __HIP_MEMORY_SCOPE_AGENT); }
__device__ __forceinline__ unsigned xb_xcc_id() { return (unsigned)__builtin_amdgcn_s_getreg((3 << 11) | 20) & 0xFu; }
#define XB_SPIN(cond, bar) do { unsigned _sp = 0; while (cond) { __builtin_amdgcn_s_sleep(1); \
    if ((++_sp & 255u) == 0u) { if (xb_ld(&(bar)[XB_TMO])) break; if (_sp > XB_SPIN_CAP) { atomicAdd(&(bar)[XB_TMO], 1u); break; } } } } while (0)
struct XcdBarrier { unsigned* bar; unsigned x; volatile LAS unsigned* st; };
__device__ __forceinline__ XcdBarrier xcd_barrier_post(unsigned* bar, volatile LAS unsigned* st) {
    XcdBarrier b; b.bar = bar; b.x = xb_xcc_id(); b.st = st;
    if (threadIdx.x == 0) (void)xb_add(&bar[XB_XCNT(b.x)], 1u);
    return b;
}
__device__ __forceinline__ void xcd_barrier_complete(unsigned* bar, unsigned x, unsigned& nloc, unsigned& nx) {
    const unsigned G = gridDim.x * gridDim.y * gridDim.z;
    unsigned sum, cnt, mine, sp = 0u;
    for (;;) {
        sum = 0u; cnt = 0u; mine = 0u;
#pragma unroll
        for (unsigned j = 0; j < 16; ++j) { const unsigned c = xb_ld(&bar[XB_XCNT(j)]); sum += c; cnt += (c > 0u) ? 1u : 0u; mine = (j == x) ? c : mine; }
        if (sum == G) break;
        __builtin_amdgcn_s_sleep(1);
        if ((++sp & 255u) == 0u) { if (xb_ld(&bar[XB_TMO])) break; if (sp > XB_SPIN_CAP) { atomicAdd(&bar[XB_TMO], 1u); break; } }
    }
    nloc = mine > 0u ? mine : 1u; nx = cnt > 0u ? cnt : 1u;
}
__device__ __forceinline__ void xcd_barrier(const XcdBarrier& b) {
    asm volatile("s_waitcnt vmcnt(0)" ::: "memory");
    __syncthreads();
    if (threadIdx.x == 0) {
        unsigned* bar = b.bar;
        __builtin_amdgcn_s_waitcnt(0);
        unsigned nloc = b.st[0], nx = b.st[1];
        if (nloc == 0u) { xcd_barrier_complete(bar, b.x, nloc, nx); b.st[0] = nloc; b.st[1] = nx; }
        const unsigned old = xb_add(&bar[XB_XSUB(b.x)], 1u);
        const unsigned gen = old / nloc;
        if (old + 1u == (gen + 1u) * nloc) {
            __builtin_amdgcn_fence(__ATOMIC_RELEASE, "agent");
            asm volatile("s_waitcnt vmcnt(0)" ::: "memory");
            const unsigned og = xb_add(&bar[XB_TOP], 1u);
            const unsigned tg = og / nx;
            if (og + 1u == (tg + 1u) * nx) xb_add(&bar[XB_TOPGEN], 1u);
            else XB_SPIN(xb_ld(&bar[XB_TOPGEN]) == tg, bar);
            __builtin_amdgcn_fence(__ATOMIC_ACQUIRE, "agent");
            xb_add(&bar[XB_XGEN(b.x)], 1u);
            asm volatile("s_waitcnt vmcnt(0)" ::: "memory");
        } else {
            XB_SPIN(xb_ld(&bar[XB_XGEN(b.x)]) == gen, bar);
            __builtin_amdgcn_fence(__ATOMIC_ACQUIRE, "agent");
            asm volatile("s_waitcnt vmcnt(0)" ::: "memory");
        }
    }
    __syncthreads();
}

struct Frame {
    LAS unsigned char* lds;
    int tid, lane, wave, vcu, G;
    long gtid, NT;
    int gw, NGW;
    const float* const* in; float* out; unsigned char* ws;
};

struct EmGU {
    bf16* HID; const float* RS;
    __device__ __forceinline__ void operator()(int gid, int row, int pn, int c8, const float (&a)[8], const float (&b)[8]) const {
        const float r = RS ? RS[row] : 1.f; float h[8];
#pragma unroll
        for (int j = 0; j < 8; ++j) h[j] = silu_f(r * a[j]) * (r * b[j]);
        *(v4u*)(HID + (size_t)row * DFF + 128 * pn + c8) = pack8(h);
    }
};
struct EmRes {
    const float* XIN; float* XF; bf16* XB; float scale;
    __device__ __forceinline__ void operator()(int gid, int row, int pn, int c8, const float (&a)[8], const float (&b)[8]) const {
#pragma unroll
        for (int hh = 0; hh < 2; ++hh) {
            const size_t off = (size_t)row * D + 256 * pn + 128 * hh + c8;
            const f32x4 x0 = *(const f32x4*)(XIN + off), x1 = *(const f32x4*)(XIN + off + 4);
            float o[8];
#pragma unroll
            for (int j = 0; j < 4; ++j) { o[j] = x0[j] + scale * (hh ? b[j] : a[j]); o[4 + j] = x1[j] + scale * (hh ? b[4 + j] : a[4 + j]); }
            *(f32x4*)(XF + off) = (f32x4){o[0], o[1], o[2], o[3]}; *(f32x4*)(XF + off + 4) = (f32x4){o[4], o[5], o[6], o[7]};
            if (XB) *(v4u*)(XB + off) = pack8(o);
        }
    }
};
struct EmInA {
    bf16 *SG, *ZB, *P; const float* RS;
    __device__ __forceinline__ void operator()(int gid, int row, int pn, int c8, const float (&a)[8], const float (&b)[8]) const {
        const float r = RS[row];
        if (pn >= 4) {
            float o[8];
#pragma unroll
            for (int j = 0; j < 8; ++j) o[j] = (r * a[j]) * (r * b[j]);
            *(v4u*)(P + (size_t)row * 512 + 128 * (pn - 4) + c8) = pack8(o);
            return;
        }
#pragma unroll
        for (int hh = 0; hh < 2; ++hh) {
            const size_t off = (size_t)row * 512 + 256 * (pn & 1) + 128 * hh + c8;
            float z[8];
#pragma unroll
            for (int j = 0; j < 8; ++j) z[j] = r * (hh ? b[j] : a[j]);
            if (pn < 2) {
#pragma unroll
                for (int j = 0; j < 8; ++j) z[j] = silu_f(z[j]);
                *(v4u*)(SG + off) = pack8(z);
            } else *(v4u*)(ZB + off) = pack8(z);
        }
    }
};
struct EmInB {
    bf16 *QT, *KT, *VT; float* LOGFT; const float* RS; const float* LB;
    __device__ __forceinline__ void operator()(int gid, int row, int pn, int c8, const float (&a)[8], const float (&b)[8]) const {
        const int kind = row >> 9, ch = row & 511;
        const float lb = LB[ch];
#pragma unroll
        for (int hh = 0; hh < 2; ++hh) {
            const int tok = 256 * pn + 128 * hh + c8; const size_t off = (size_t)ch * M + tok;
            const f32x4 r0 = *(const f32x4*)(RS + tok), r1 = *(const f32x4*)(RS + tok + 4);
            float z[8], o[8];
#pragma unroll
            for (int j = 0; j < 8; ++j) z[j] = (j < 4 ? r0[j] : r1[j - 4]) * (hh ? b[j] : a[j]);
            if (kind == 0) {
#pragma unroll
                for (int j = 0; j < 8; ++j) o[j] = silu_f(z[j]) * 0.08838834764831845f;
                *(v4u*)(QT + off) = pack8(o);
            } else if (kind == 1) {
                float lf[8];
#pragma unroll
                for (int j = 0; j < 8; ++j) { const float f = lb + (1.f - lb) * sigm_f(z[j]); o[j] = 1.f - f; lf[j] = __logf(f); }
                *(v4u*)(KT + off) = pack8(o);
                *(f32x4*)(LOGFT + off) = (f32x4){lf[0], lf[1], lf[2], lf[3]}; *(f32x4*)(LOGFT + off + 4) = (f32x4){lf[4], lf[5], lf[6], lf[7]};
            } else *(v4u*)(VT + off) = pack8(z);
        }
    }
};
struct EmPlain {
    bf16* O; const float* RS; float scale;
    __device__ __forceinline__ void operator()(int gid, int row, int pn, int c8, const float (&a)[8], const float (&b)[8]) const {
        const float r = (RS ? RS[row] : 1.f) * scale; float o[8];
#pragma unroll
        for (int j = 0; j < 8; ++j) o[j] = r * a[j];
        *(v4u*)(O + (size_t)row * 1024 + 256 * pn + c8) = pack8(o);
#pragma unroll
        for (int j = 0; j < 8; ++j) o[j] = r * b[j];
        *(v4u*)(O + (size_t)row * 1024 + 256 * pn + 128 + c8) = pack8(o);
    }
};


namespace pg8 {
#define PG8_LAS __attribute__((address_space(3)))
typedef unsigned short bf16_t;
typedef short bf16x8 __attribute__((ext_vector_type(8)));
typedef unsigned u32x4 __attribute__((ext_vector_type(4)));
constexpr int BM = 256, BK = 64, HALF = 128, HTB = HALF * BK * 2, STAGE_BYTES = 8 * HTB, NXCD = 8, WGM = 8;
__host__ __device__ __forceinline__ int lds_byte(int r, int c) { const int st = (r >> 4) * 2 + (c >> 5), rr = r & 15, cc = c & 31, ob = rr * 64 + cc * 2; return st * 1024 + (ob ^ (((ob >> 9) & 1) << 5)); }
__host__ __device__ __forceinline__ void stage_rc(int b, int& R, int& C) { const int st = b / 1024, sb = b % 1024, swz = sb ^ (((sb >> 9) & 1) << 5); R = (st >> 1) * 16 + swz / 64; C = (st & 1) * 32 + (swz % 64) / 2; }
__host__ __device__ __forceinline__ int perm32(int rho) { const int n = rho >> 4, i = rho & 15; return 8 * (i >> 2) + 4 * n + (i & 3); }
struct Unit { int pm, pn, gid; };
__device__ __forceinline__ void order_map(int L, int nM, int nN, Unit& u) {
    const int nwg = nM * nN; int wgid = L; { const int q = nwg / NXCD, r = nwg % NXCD, xcd = wgid % NXCD, off = wgid / NXCD; wgid = (xcd < r ? xcd * (q + 1) : r * (q + 1) + (xcd - r) * q) + off; }
    const int nig = WGM * nN, gid = wgid / nig, fm = gid * WGM, gsz = (nM - fm) < WGM ? (nM - fm) : WGM;
    u.pm = fm + ((wgid % nig) % gsz); u.pn = (wgid % nig) / gsz;
}
struct Sched1 {
    const bf16_t* A; const bf16_t* Bt; int nM, nN, G, c;
    __device__ __forceinline__ bool next(int i, Unit& u) const { const long L = (long)i * G + c; if (c < 0 || L >= (long)nM * nN) return false; order_map((int)L, nM, nN, u); u.gid = 0; return true; }
    __device__ __forceinline__ const char* tileA(const Unit& u, size_t tstep) const { return (const char*)A + (size_t)u.pm * tstep; }
    __device__ __forceinline__ const char* tileB(const Unit& u, size_t tstep) const { return (const char*)Bt + (size_t)u.pn * tstep; }
    __device__ __forceinline__ void a_ready(const Unit&) const {}
    __device__ __forceinline__ void done(const Unit&) const {}
};
template <class Emit> struct EpiEmit {
    static constexpr bool PERM = true, AFTER_DRAIN = false; Emit E;
    __device__ __forceinline__ void operator()(const f32x4 (&acc)[2][2][4][2], const Unit& u, int wr, int wc, int fr, int fq) const {
#pragma unroll
        for (int ai = 0; ai < 2; ++ai)
#pragma unroll
            for (int m = 0; m < 4; ++m) {
                float a[8], b[8];
#pragma unroll
                for (int j = 0; j < 8; ++j) { a[j] = acc[ai][0][m][j >> 2][j & 3]; b[j] = acc[ai][1][m][j >> 2][j & 3]; }
                E(u.gid, u.pm * BM + ai * HALF + wr * 64 + m * 16 + fr, u.pn, wc * 32 + fq * 8, a, b);
            }
    }
};
template <class Epi, class Sched, bool ALIGN_EPI = false, bool SP2 = false>
__device__ __forceinline__ void gemm_phase(PG8_LAS unsigned char* lds, const int K, const Sched& S, const Epi& E) {
    const int tid = threadIdx.x, wid = __builtin_amdgcn_readfirstlane(tid >> 6), lane = tid & 63, wr = wid >> 2, wc = wid & 3, fr = lane & 15, fq = lane >> 4;
    const int nt = K / BK;
    unsigned voffA[2], voffB[2];
#pragma unroll
    for (int i = 0; i < 2; ++i) { int R, C; stage_rc(tid * 16 + i * 8192, R, C); const int Rb = Epi::PERM ? ((R & ~31) + perm32(R & 31)) : R;
        voffA[i] = (unsigned)(R * K + C) * 2u; voffB[i] = (unsigned)(Rb * K + C) * 2u; }
    const size_t kstep = (size_t)(BK * 2);
    const size_t hstep = (size_t)HALF * K * 2;
    const size_t tstep = 2 * hstep;
    const unsigned ldsw = (unsigned)wid * 1024u;
    const int aoff = lds_byte(wr * 64 + fr, fq * 8), boff = lds_byte(wc * 32 + fr, fq * 8);
#define PG8_SA(b, h) (((b) * 2 + (h)) * HTB)
#define PG8_SB(b, h) ((4 + (b) * 2 + (h)) * HTB)
#define PG8_STAGE(bufoff, gbase, voff) do { _Pragma("unroll") for (int _i = 0; _i < 2; ++_i) \
        __builtin_amdgcn_global_load_lds((const unsigned*)((const char*)(gbase) + (voff)[_i]), (PG8_LAS unsigned*)(lds + (bufoff) + ldsw + _i * 8192), 16, 0, 0); } while (0)
#define PG8_LDA(dst, b, h) do { _Pragma("unroll") for (int m = 0; m < 4; ++m) _Pragma("unroll") for (int k = 0; k < 2; ++k) dst[m][k] = *(const PG8_LAS bf16x8*)(lds + PG8_SA(b, h) + aoff + m * 2048 + k * 1024); } while (0)
#define PG8_LDB(dst, b, h) do { _Pragma("unroll") for (int n = 0; n < 2; ++n) _Pragma("unroll") for (int k = 0; k < 2; ++k) dst[n][k] = *(const PG8_LAS bf16x8*)(lds + PG8_SB(b, h) + boff + n * 2048 + k * 1024); } while (0)
#define PG8_MMA(ai, bj, At, Bt) do { __builtin_amdgcn_s_setprio(1); _Pragma("unroll") for (int m = 0; m < 4; ++m) _Pragma("unroll") for (int n = 0; n < 2; ++n) _Pragma("unroll") for (int k = 0; k < 2; ++k) \
        acc[ai][bj][m][n] = __builtin_amdgcn_mfma_f32_16x16x32_bf16(Bt[n][k], At[m][k], acc[ai][bj][m][n], 0, 0, 0); __builtin_amdgcn_s_setprio(0); } while (0)
#define PG8_WAIT_V(n) asm volatile("s_waitcnt vmcnt(" #n ")" ::: "memory")
#define PG8_WAIT_L(n) asm volatile("s_waitcnt lgkmcnt(" #n ")" ::: "memory")
#define PG8_BAR __builtin_amdgcn_s_barrier()
#define PG8_SCHED __builtin_amdgcn_sched_barrier(0)
    Unit cur, nxt; int ui = 0;
    if (!S.next(0, cur)) return;
    f32x4 acc[2][2][4][2];
#pragma unroll
    for (int a = 0; a < 2; ++a)
#pragma unroll
        for (int b = 0; b < 2; ++b)
#pragma unroll
            for (int m = 0; m < 4; ++m)
#pragma unroll
                for (int n = 0; n < 2; ++n) acc[a][b][m][n] = (f32x4){0.f, 0.f, 0.f, 0.f};
    bf16x8 At[4][2], B0[2][2], B1[2][2];
    const char* cA = S.tileA(cur, tstep); const char* cB = S.tileB(cur, tstep);
    S.a_ready(cur);
    if constexpr (SP2) {
        PG8_STAGE(PG8_SB(0, 0), cB, voffB); PG8_STAGE(PG8_SB(0, 1), cB + hstep, voffB); PG8_STAGE(PG8_SA(0, 0), cA, voffA); PG8_STAGE(PG8_SA(0, 1), cA + hstep, voffA);
        if (wr == 1) PG8_BAR;
        PG8_WAIT_V(2); PG8_BAR;
        PG8_STAGE(PG8_SB(1, 0), cB + kstep, voffB); PG8_STAGE(PG8_SA(1, 0), cA + kstep, voffA); PG8_STAGE(PG8_SB(1, 1), cB + hstep + kstep, voffB);
        PG8_WAIT_V(6); PG8_BAR;
    } else {
        PG8_STAGE(PG8_SB(0, 0), cB, voffB); PG8_STAGE(PG8_SA(0, 0), cA, voffA); PG8_STAGE(PG8_SB(0, 1), cB + hstep, voffB); PG8_STAGE(PG8_SA(0, 1), cA + hstep, voffA);
        if (wr == 1) PG8_BAR;
        PG8_WAIT_V(4); PG8_BAR;
        PG8_STAGE(PG8_SB(1, 0), cB + kstep, voffB); PG8_STAGE(PG8_SA(1, 0), cA + kstep, voffA); PG8_STAGE(PG8_SB(1, 1), cB + hstep + kstep, voffB);
        PG8_WAIT_V(6); PG8_BAR;
    }
    for (;;) {
        const bool has_next = S.next(ui + 1, nxt);
        const char* nA = has_next ? S.tileA(nxt, tstep) : cA; const char* nB = has_next ? S.tileB(nxt, tstep) : cB;
        for (int t = 0; t < nt; t += 2) {
            const bool last = (t == nt - 2);
            const char* a1 = cA + (size_t)(t + 1) * kstep;
            const char* a2 = last ? nA : cA + (size_t)(t + 2) * kstep; const char* b2 = last ? nB : cB + (size_t)(t + 2) * kstep;
            const char* a3 = a2 + kstep; const char* b3 = b2 + kstep;
            if (last && has_next) S.a_ready(nxt);
            if constexpr (SP2) {
            PG8_LDB(B0, 0, 0); PG8_LDB(B1, 0, 1); PG8_SCHED; PG8_LDA(At, 0, 0); PG8_STAGE(PG8_SA(1, 1), a1 + hstep, voffA);
            PG8_WAIT_V(8); PG8_WAIT_L(0); PG8_BAR; PG8_MMA(0, 0, At, B0); PG8_MMA(0, 1, At, B1); PG8_BAR; PG8_SCHED;
            PG8_LDA(At, 0, 1); PG8_STAGE(PG8_SB(0, 0), b2, voffB); PG8_STAGE(PG8_SB(0, 1), b2 + hstep, voffB); PG8_STAGE(PG8_SA(0, 0), a2, voffA);
            PG8_WAIT_V(8); PG8_WAIT_L(0); PG8_BAR; PG8_MMA(1, 0, At, B0); PG8_MMA(1, 1, At, B1); PG8_BAR; PG8_SCHED;
            PG8_LDB(B0, 1, 0); PG8_LDB(B1, 1, 1); PG8_SCHED; PG8_LDA(At, 1, 0); PG8_STAGE(PG8_SA(0, 1), a2 + hstep, voffA);
            PG8_WAIT_V(8); PG8_WAIT_L(0); PG8_BAR; PG8_MMA(0, 0, At, B0); PG8_MMA(0, 1, At, B1); PG8_BAR; PG8_SCHED;
            PG8_LDA(At, 1, 1); PG8_STAGE(PG8_SB(1, 0), b3, voffB); PG8_STAGE(PG8_SB(1, 1), b3 + hstep, voffB); PG8_STAGE(PG8_SA(1, 0), a3, voffA);
            PG8_WAIT_V(8); PG8_WAIT_L(0); PG8_BAR; PG8_MMA(1, 0, At, B0); PG8_MMA(1, 1, At, B1); PG8_BAR; PG8_SCHED;
            } else {
            PG8_LDB(B0, 0, 0); PG8_SCHED; PG8_LDA(At, 0, 0); PG8_STAGE(PG8_SA(1, 1), a1 + hstep, voffA);
            PG8_WAIT_L(8); PG8_BAR; PG8_WAIT_L(0); PG8_MMA(0, 0, At, B0); PG8_BAR; PG8_SCHED;
            PG8_LDB(B1, 0, 1); PG8_STAGE(PG8_SB(0, 0), b2, voffB);
            PG8_BAR; PG8_WAIT_L(0); PG8_MMA(0, 1, At, B1); PG8_BAR;
            PG8_LDA(At, 0, 1); PG8_STAGE(PG8_SA(0, 0), a2, voffA);
            PG8_BAR; PG8_WAIT_L(0); PG8_MMA(1, 0, At, B0); PG8_BAR; PG8_SCHED;
            PG8_STAGE(PG8_SB(0, 1), b2 + hstep, voffB);
            PG8_WAIT_V(6); PG8_BAR; PG8_MMA(1, 1, At, B1); PG8_BAR;
            PG8_LDB(B0, 1, 0); PG8_SCHED; PG8_LDA(At, 1, 0); PG8_STAGE(PG8_SA(0, 1), a2 + hstep, voffA);
            PG8_WAIT_L(8); PG8_BAR; PG8_WAIT_L(0); PG8_MMA(0, 0, At, B0); PG8_BAR; PG8_SCHED;
            PG8_LDB(B1, 1, 1); PG8_STAGE(PG8_SB(1, 0), b3, voffB);
            PG8_BAR; PG8_WAIT_L(0); PG8_MMA(0, 1, At, B1); PG8_BAR;
            PG8_LDA(At, 1, 1); PG8_STAGE(PG8_SA(1, 0), a3, voffA);
            PG8_BAR; PG8_WAIT_L(0); PG8_MMA(1, 0, At, B0); PG8_BAR; PG8_SCHED;
            PG8_STAGE(PG8_SB(1, 1), b3 + hstep, voffB);
            PG8_WAIT_V(6); PG8_BAR; PG8_MMA(1, 1, At, B1); PG8_BAR;
            }
        }
        if constexpr (ALIGN_EPI) { if (wr == 0) PG8_BAR; }
        if constexpr (!Epi::AFTER_DRAIN) { E(acc, cur, wr, wc, fr, fq); S.done(cur); }
        if (!has_next) break;
#pragma unroll
        for (int a = 0; a < 2; ++a)
#pragma unroll
            for (int b = 0; b < 2; ++b)
#pragma unroll
                for (int m = 0; m < 4; ++m)
#pragma unroll
                    for (int n = 0; n < 2; ++n) acc[a][b][m][n] = (f32x4){0.f, 0.f, 0.f, 0.f};
        cur = nxt; cA = nA; cB = nB; ++ui;
        if constexpr (ALIGN_EPI) { if (wr == 1) PG8_BAR; }
    }
    PG8_WAIT_V(0);
    if constexpr (!ALIGN_EPI) { if (wr == 0) PG8_BAR; }
    PG8_BAR;
    if constexpr (Epi::AFTER_DRAIN) { E.fused(acc, cur, wr, wc, fr, fq, lds, wid, lane); S.done(cur); }
#undef PG8_SA
#undef PG8_SB
#undef PG8_STAGE
#undef PG8_LDA
#undef PG8_LDB
#undef PG8_MMA
#undef PG8_WAIT_V
#undef PG8_WAIT_L
#undef PG8_BAR
#undef PG8_SCHED
}
}

template <class Emit>
__device__ __forceinline__ void naive_gemm(const Frame& F, const bf16* A, const bf16* Bt, int Mr, int N, int K, const Emit& E) {
    const long nitem = (long)Mr * (N / 256) * 16;
    for (long i = F.gtid; i < nitem; i += F.NT) {
        const int l = (int)(i & 63); const long g = i >> 6; const int rg = (int)(g % (Mr / 4)), pn = (int)(g / (Mr / 4));
        const int row = rg * 4 + (l >> 4), c8 = (l & 15) * 8;
        float a[8], b[8];
#pragma unroll
        for (int j = 0; j < 8; ++j) { a[j] = 0.f; b[j] = 0.f; }
        const bf16* ap = A + (size_t)row * K; const bf16* bp = Bt + (size_t)(256 * pn + c8) * K;
        for (int k = 0; k < K; k += 8) {
            float av[8]; unpack8(*(const v4u*)(ap + k), av);
#pragma unroll
            for (int j = 0; j < 8; ++j) {
                float bv[8]; unpack8(*(const v4u*)(bp + (size_t)j * K + k), bv);
                float cv[8]; unpack8(*(const v4u*)(bp + (size_t)(128 + j) * K + k), cv);
#pragma unroll
                for (int e = 0; e < 8; ++e) { a[j] += av[e] * bv[e]; b[j] += av[e] * cv[e]; }
            }
        }
        E(0, row, pn, c8, a, b);
    }
}

__device__ __forceinline__ void transpose_item(const float* W, int ldw, int col0, const float* g, bf16* WT, int Kd, int n0, int k0, LAS float* scr, int lane) {
#pragma unroll 8
    for (int i = 0; i < 32; ++i) { const int kk = 2 * i + (lane >> 5); const float gv = g ? g[k0 + kk] : 1.f; scr[kk * 33 + (lane & 31)] = W[(size_t)(k0 + kk) * ldw + col0 + (lane & 31)] * gv; }
    asm volatile("s_waitcnt lgkmcnt(0)" ::: "memory");
    const int c = lane & 7;
#pragma unroll
    for (int j = 0; j < 4; ++j) { const int n = (lane >> 3) + 8 * j; const LAS float* s = scr + (8 * c) * 33 + n;
        v4u o; o.x = pk2(s[0 * 33], s[1 * 33]); o.y = pk2(s[2 * 33], s[3 * 33]); o.z = pk2(s[4 * 33], s[5 * 33]); o.w = pk2(s[6 * 33], s[7 * 33]);
        *(v4u*)(WT + (size_t)(n0 + n) * Kd + k0 + 8 * c) = o; }
    asm volatile("s_waitcnt lgkmcnt(0)" ::: "memory");
}
__device__ __forceinline__ void norm_row_bf16(const float* xrow, const float* gain, bf16* orow, int lane) {
    const f32x4* xr = (const f32x4*)xrow + lane; f32x4 v[4]; float s = 0.f;
#pragma unroll
    for (int j = 0; j < 4; ++j) { v[j] = xr[64 * j]; s += (v[j].x * v[j].x + v[j].y * v[j].y) + (v[j].z * v[j].z + v[j].w * v[j].w); }
    const float r = 1.f / sqrtf(wave_sum(s) * (1.f / D) + EPS);
    v2u* o8 = (v2u*)orow + lane;
#pragma unroll
    for (int j = 0; j < 4; ++j) { f32x4 gg = gain ? ((const f32x4*)gain)[lane + 64 * j] : (f32x4){1.f, 1.f, 1.f, 1.f};
        v2u w; w.x = pk2(v[j].x * r * gg.x, v[j].y * r * gg.y); w.y = pk2(v[j].z * r * gg.z, v[j].w * r * gg.w); o8[64 * j] = w; }
}
__device__ __forceinline__ void p_prologue(const Frame& F) {
    LAS float* scr = (LAS float*)(F.lds + F.wave * 16384);
    unsigned char* ws = F.ws;
    constexpr int I_GU = 16 * (NGU / 32), I_D = (DFF / 64) * (D / 32), I_IN = 16 * (INC / 32), I_SQ = 16 * 32, I_KV = 16 * 64;
    constexpr int NITEMS = 2 * I_GU + 2 * I_D + I_IN + 3 * I_SQ + I_KV;
    for (int it = F.gw; it < NITEMS; it += F.NGW) {
        int r = it;
        if (r < 2 * I_GU) {
            const int which = r / I_GU; r -= which * I_GU; const int nb = r % (NGU / 32), kb = r / (NGU / 32), n0 = 32 * nb, t = n0 / 256, w = n0 % 256, half = w / 128, col = 128 * t + (w % 128);
            const float* W = F.in[(which ? 18 : 3) + half]; const float* g = F.in[which ? 17 : 2];
            transpose_item(W, DFF, col, g, (bf16*)(ws + (which ? WS_WGU2 : WS_WGU1)), D, n0, 64 * kb, scr, F.lane); continue; }
        r -= 2 * I_GU;
        if (r < 2 * I_D) { const int which = r / I_D; r -= which * I_D; const int nb = r % (D / 32), kb = r / (D / 32);
            transpose_item(F.in[which ? 20 : 5], D, 32 * nb, nullptr, (bf16*)(ws + (which ? WS_WD2 : WS_WD1)), DFF, 32 * nb, 64 * kb, scr, F.lane); continue; }
        r -= 2 * I_D;
        if (r < I_IN) { const int nb = r % (INC / 32), kb = r / (INC / 32), n0 = 32 * nb; int col = n0;
            if (n0 >= 2560) { const int t = (n0 - 2560) / 256, w = (n0 - 2560) % 256, half = w / 128; col = (half ? 3072 : 2560) + 128 * t + (w % 128); }
            transpose_item(F.in[7], INC, col, F.in[6], (bf16*)(ws + WS_WIN), D, n0, 64 * kb, scr, F.lane); continue; }
        r -= I_IN;
        if (r < 3 * I_SQ) { const int which = r / I_SQ; r -= which * I_SQ; const int nb = r % 32, kb = r / 32;
            const float* W = F.in[which == 0 ? 11 : (which == 1 ? 14 : 16)]; const float* g = which == 1 ? F.in[12] : nullptr;
            bf16* dst = (bf16*)(ws + (which == 0 ? WS_WOUT : (which == 1 ? WS_WQ : WS_WO)));
            transpose_item(W, D, 32 * nb, g, dst, D, 32 * nb, 64 * kb, scr, F.lane); continue; }
        r -= 3 * I_SQ;
        { const int nb = r % 64, kb = r / 64; transpose_item(F.in[15], 2 * D, 32 * nb, nullptr, (bf16*)(ws + WS_WKV), D, 32 * nb, 64 * kb, scr, F.lane); }
    }
    for (int m = F.gw; m < M; m += F.NGW) norm_row_bf16(F.in[0] + (size_t)m * D, nullptr, (bf16*)(ws + WS_XN) + (size_t)m * D, F.lane);
    for (int m = F.gw; m < MROWS; m += F.NGW) norm_row_bf16(F.in[1] + (size_t)m * D, F.in[13], (bf16*)(ws + WS_MN) + (size_t)m * D, F.lane);
    if (F.gtid < HF) { const float p0 = F.in[8][F.gtid], p1 = F.in[8][HF + F.gtid]; const float mx = fmaxf(p0, p1), e0 = __expf(p0 - mx), e1 = __expf(p1 - mx);
        ((float*)(ws + WS_LB))[F.gtid] = e0 / (e0 + e1); }
}

__device__ __forceinline__ void p_rowstat(const Frame& F) {
    float* RS = (float*)(F.ws + WS_RS);
    for (int m = F.gw; m < M; m += F.NGW) {
        const f32x4* xr = (const f32x4*)(F.out + (size_t)m * D) + F.lane; float s = 0.f;
#pragma unroll
        for (int j = 0; j < 4; ++j) { const f32x4 v = xr[64 * j]; s += (v.x * v.x + v.y * v.y) + (v.z * v.z + v.w * v.w); }
        s = wave_sum(s);
        if (F.lane == 0) RS[m] = 1.f / sqrtf(s * (1.f / D) + EPS);
    }
}
__device__ __forceinline__ void p_final(const Frame& F) {
    const float* g = F.in[21];
    for (int m = F.gw; m < M; m += F.NGW) {
        f32x4* xr = (f32x4*)(F.out + (size_t)m * D) + F.lane; f32x4 v[4]; float s = 0.f;
#pragma unroll
        for (int j = 0; j < 4; ++j) { v[j] = xr[64 * j]; s += (v[j].x * v[j].x + v[j].y * v[j].y) + (v[j].z * v[j].z + v[j].w * v[j].w); }
        const float r = 1.f / sqrtf(wave_sum(s) * (1.f / D) + EPS);
#pragma unroll
        for (int j = 0; j < 4; ++j) { const f32x4 gg = ((const f32x4*)g)[F.lane + 64 * j]; xr[64 * j] = (f32x4){v[j].x * r * gg.x, v[j].y * r * gg.y, v[j].z * r * gg.z, v[j].w * r * gg.w}; }
    }
}

__device__ __forceinline__ void p_conv(const Frame& F) {
    const bf16* ZB = (const bf16*)(F.ws + WS_ZB); const bf16* P = (const bf16*)(F.ws + WS_P); bf16* Y = (bf16*)(F.ws + WS_Y); const float* cw = F.in[10];
    const long nitem = (long)M * 64;
    for (long i = F.gtid; i < nitem; i += F.NT) {
        const int row = (int)(i >> 6), c8 = (int)(i & 63) * 8, t = row % SEQ;
        float zb[8], p0[8], p1[8], p2[8], o[8];
        unpack8(*(const v4u*)(ZB + (size_t)row * 512 + c8), zb);
        unpack8(*(const v4u*)(P + (size_t)row * 512 + c8), p2);
        if (t >= 1) unpack8(*(const v4u*)(P + (size_t)(row - 1) * 512 + c8), p1); else {
#pragma unroll
            for (int j = 0; j < 8; ++j) p1[j] = 0.f; }
        if (t >= 2) unpack8(*(const v4u*)(P + (size_t)(row - 2) * 512 + c8), p0); else {
#pragma unroll
            for (int j = 0; j < 8; ++j) p0[j] = 0.f; }
#pragma unroll
        for (int j = 0; j < 8; ++j) { const float* w = cw + (c8 + j) * 3; o[j] = zb[j] * (w[0] * p0[j] + w[1] * p1[j] + w[2] * p2[j]); }
        *(v4u*)(Y + (size_t)row * D + 512 + c8) = pack8(o);
    }
}

__device__ __forceinline__ void p_scan_simple(const Frame& F) {
    const bf16* Q = (const bf16*)(F.ws + WS_Q); const bf16* KK = (const bf16*)(F.ws + WS_KK); const bf16* V = (const bf16*)(F.ws + WS_V); const float* LOGF = (const float*)(F.ws + WS_LOGF);
    float* O32 = (float*)(F.ws + WS_DS);
    if (F.gtid < BATCH * NH * DV) {
    const int dv = (int)(F.gtid % DV), h = (int)(F.gtid / DV) % NH, b = (int)(F.gtid / (DV * NH));
    float S[DK];
#pragma unroll
    for (int i = 0; i < DK; ++i) S[i] = 0.f;
    for (int t = 0; t < SEQ; ++t) {
        const size_t tok = (size_t)b * SEQ + t;
        const float v = bf2f(V[(size_t)(h * 128 + dv) * M + tok]); float o = 0.f;
        const float* lp = LOGF + (size_t)(h * 128) * M + tok; const bf16* kp = KK + (size_t)(h * 128) * M + tok; const bf16* qp = Q + (size_t)(h * 128) * M + tok;
#pragma unroll
        for (int i = 0; i < DK; ++i) {
            const float f = __expf(*lp); S[i] = f * S[i] + bf2f(*kp) * v; o += S[i] * bf2f(*qp);
            lp += M; kp += M; qp += M; asm volatile("" : "+v"(lp), "+v"(kp), "+v"(qp));
        }
        O32[((size_t)b * SEQ + t) * 512 + h * 128 + dv] = o;
    }
    }
}
__device__ __forceinline__ void p_hnorm_simple(const Frame& F) {
    const float* O32 = (const float*)(F.ws + WS_DS); const bf16* SG = (const bf16*)(F.ws + WS_SG); bf16* Y = (bf16*)(F.ws + WS_Y); const float* g = F.in[9];
    for (int it = F.gw; it < M * NH; it += F.NGW) {
        const int row = it >> 2, h = it & 3; const size_t off = (size_t)row * 512 + h * 128 + 2 * F.lane;
        const float o0 = O32[off], o1 = O32[off + 1];
        const float r = 1.f / sqrtf(wave_sum(o0 * o0 + o1 * o1) * (1.f / DV) + EPS);
        const unsigned sg = *(const unsigned*)(SG + off);
        *(unsigned*)(Y + (size_t)row * D + h * 128 + 2 * F.lane) = pk2(o0 * r * g[h * 128 + 2 * F.lane] * bflo(sg), o1 * r * g[h * 128 + 2 * F.lane + 1] * bfhi(sg));
    }
}


typedef short bf16x8 __attribute__((ext_vector_type(8)));
typedef short bf16x4 __attribute__((ext_vector_type(4)));
#define MFMA16(a, b, c) __builtin_amdgcn_mfma_f32_16x16x32_bf16((a), (b), (c), 0, 0, 0)
__device__ __forceinline__ v2u pk4(f32x4 v) { v2u w; w.x = pk2(v[0], v[1]); w.y = pk2(v[2], v[3]); return w; }

struct ChunkRegs { f32x4 lf[4]; v4u kw[2]; v4u qw[2]; v4u vw[2]; };
template <bool WITH_Q>
__device__ __forceinline__ void chunk_load(ChunkRegs& R, const unsigned char* ws, int u, int dk, int sq) {
    const int c = u & 63, h = (u >> 6) & 3, b = u >> 8;
    const size_t roff = (size_t)(h * 128 + dk) * M + (size_t)b * SEQ + c * 64 + sq * 16;
    const float* LOGFT = (const float*)(ws + WS_LOGF) + roff; const bf16* KT = (const bf16*)(ws + WS_KK) + roff; const bf16* VT = (const bf16*)(ws + WS_V) + roff; const bf16* QT = (const bf16*)(ws + WS_Q) + roff;
#pragma unroll
    for (int i = 0; i < 4; ++i) R.lf[i] = *(const f32x4*)(LOGFT + 4 * i);
#pragma unroll
    for (int i = 0; i < 2; ++i) { R.kw[i] = *(const v4u*)(KT + 8 * i); R.vw[i] = *(const v4u*)(VT + 8 * i); if (WITH_Q) R.qw[i] = *(const v4u*)(QT + 8 * i); }
}
__device__ __forceinline__ float chunk_cumsum(const ChunkRegs& R, int lane, int sq, float (&bt)[16]) {
    float run = 0.f;
#pragma unroll
    for (int i = 0; i < 16; ++i) { run += R.lf[i >> 2][i & 3]; bt[i] = run; }
    const int base = lane & ~3;
    const float t0 = __shfl(run, base), t1 = __shfl(run, base + 1), t2 = __shfl(run, base + 2), t3 = __shfl(run, base + 3);
    const float pre = (sq > 0 ? t0 : 0.f) + (sq > 1 ? t1 : 0.f) + (sq > 2 ? t2 : 0.f);
#pragma unroll
    for (int i = 0; i < 16; ++i) bt[i] += pre;
    return (t0 + t1) + (t2 + t3);
}
constexpr int NUNIT = BATCH * NH * NCHUNK;
__device__ __forceinline__ void p_scanA(const Frame& F) {
    unsigned char* ws = F.ws; bf16* DS = (bf16*)(ws + WS_DS); float* DEC = (float*)(ws + WS_DEC);
    LAS unsigned char* KhT = F.lds; LAS unsigned char* VTl = F.lds + 18432;
    const int tid = F.tid, lane = F.lane, w = F.wave, dk = tid >> 2, sq = tid & 3, i16 = lane & 15, q4 = lane >> 4;
    ChunkRegs R;
    int u = F.vcu; if (u < NUNIT) chunk_load<false>(R, ws, u, dk, sq);
    for (; u < NUNIT; u += F.G) {
        float bt[16]; const float tot = chunk_cumsum(R, lane, sq, bt);
        float kf[16]; { float t8[8]; unpack8(R.kw[0], t8);
#pragma unroll
            for (int j = 0; j < 8; ++j) kf[j] = t8[j]; unpack8(R.kw[1], t8);
#pragma unroll
            for (int j = 0; j < 8; ++j) kf[8 + j] = t8[j]; }
        float o0[8], o1[8];
#pragma unroll
        for (int j = 0; j < 8; ++j) { o0[j] = kf[j] * __expf(tot - bt[j]); o1[j] = kf[8 + j] * __expf(tot - bt[8 + j]); }
        *(LAS v4u*)(KhT + dk * 144 + sq * 32) = pack8(o0); *(LAS v4u*)(KhT + dk * 144 + sq * 32 + 16) = pack8(o1);
        *(LAS v4u*)(VTl + dk * 144 + sq * 32) = R.vw[0]; *(LAS v4u*)(VTl + dk * 144 + sq * 32 + 16) = R.vw[1];
        if (sq == 0) DEC[(size_t)u * 128 + dk] = __expf(tot);
        __syncthreads();
        if (u + F.G < NUNIT) chunk_load<false>(R, ws, u + F.G, dk, sq);
        const bf16x8 a0 = *(const LAS bf16x8*)(KhT + (16 * w + i16) * 144 + q4 * 16), a1 = *(const LAS bf16x8*)(KhT + (16 * w + i16) * 144 + 64 + q4 * 16);
#pragma unroll
        for (int dvb = 0; dvb < 8; ++dvb) {
            const bf16x8 b0 = *(const LAS bf16x8*)(VTl + (16 * dvb + i16) * 144 + q4 * 16), b1 = *(const LAS bf16x8*)(VTl + (16 * dvb + i16) * 144 + 64 + q4 * 16);
            f32x4 acc = (f32x4){0.f, 0.f, 0.f, 0.f};
            acc = MFMA16(a0, b0, acc); acc = MFMA16(a1, b1, acc);
            *(v2u*)(DS + (size_t)u * 16384 + (16 * dvb + i16) * 128 + 16 * w + 4 * q4) = pk4(acc);
        }
        __syncthreads();
    }
}
__device__ __forceinline__ void p_scanB(const Frame& F) {
    unsigned* DSu = (unsigned*)(F.ws + WS_DS); const float* DEC = (const float*)(F.ws + WS_DEC);
    for (long e = F.gtid; e < (long)BATCH * NH * 8192; e += F.NT) {
        const int bh = (int)(e >> 13), pr = (int)(e & 8191), dk = (2 * pr) & 127;
        unsigned* p = DSu + (size_t)bh * 64 * 8192 + pr; const float* dec = DEC + (size_t)bh * 64 * 128 + dk;
        float S0 = 0.f, S1 = 0.f;
        for (int c0 = 0; c0 < NCHUNK; c0 += 16) {
            unsigned wv[16]; float d0[16], d1[16];
#pragma unroll
            for (int j = 0; j < 16; ++j) { wv[j] = p[(size_t)(c0 + j) * 8192]; d0[j] = dec[(c0 + j) * 128]; d1[j] = dec[(c0 + j) * 128 + 1]; }
#pragma unroll
            for (int j = 0; j < 16; ++j) { p[(size_t)(c0 + j) * 8192] = pk2(S0, S1); S0 = d0[j] * S0 + bflo(wv[j]); S1 = d1[j] * S1 + bfhi(wv[j]); }
        }
    }
}
constexpr int LC_QS = 0, LC_KS = 17408, LC_VT = 34816, LC_P = 53248, LC_ST = 62464, LC_RED = 97280;
__device__ __forceinline__ void p_scanC(const Frame& F) {
    unsigned char* ws = F.ws; const bf16* DS = (const bf16*)(ws + WS_DS); const bf16* SG = (const bf16*)(ws + WS_SG); bf16* Y = (bf16*)(ws + WS_Y); const float* gh = F.in[9];
    LAS unsigned char* L = F.lds;
    const int tid = F.tid, lane = F.lane, w = F.wave, dk = tid >> 2, sq = tid & 3, i16 = lane & 15, q4 = lane >> 4;
    ChunkRegs R; v4u st[4];
    int u = F.vcu;
    if (u < NUNIT) { chunk_load<true>(R, ws, u, dk, sq);
#pragma unroll
        for (int i = 0; i < 4; ++i) { const int p = tid + 512 * i; st[i] = *(const v4u*)(DS + (size_t)u * 16384 + (p >> 4) * 128 + (p & 15) * 8); } }
    for (; u < NUNIT; u += F.G) {
        const int c = u & 63, h = (u >> 6) & 3, b = u >> 8;
        float bt[16]; (void)chunk_cumsum(R, lane, sq, bt);
        { float kf[8], qf[8];
#pragma unroll
          for (int hh = 0; hh < 2; ++hh) { unpack8(R.kw[hh], kf); unpack8(R.qw[hh], qf);
#pragma unroll
            for (int j = 0; j < 8; ++j) { const int t = 16 * sq + 8 * hh + j; const float e = __expf(bt[8 * hh + j]);
                const int off = t * 272 + ((dk >> 3) ^ (2 * sq)) * 16 + (dk & 7) * 2;
                *(LAS bf16*)(L + LC_QS + off) = (bf16)f2bf(qf[j] * e); *(LAS bf16*)(L + LC_KS + off) = (bf16)f2bf(kf[j] / e); } } }
        *(LAS v4u*)(L + LC_VT + dk * 144 + sq * 32) = R.vw[0]; *(LAS v4u*)(L + LC_VT + dk * 144 + sq * 32 + 16) = R.vw[1];
#pragma unroll
        for (int i = 0; i < 4; ++i) { const int p = tid + 512 * i; *(LAS v4u*)(L + LC_ST + (p >> 4) * 272 + (p & 15) * 16) = st[i]; }
        __syncthreads();
        if (u + F.G < NUNIT) { chunk_load<true>(R, ws, u + F.G, dk, sq);
#pragma unroll
            for (int i = 0; i < 4; ++i) { const int p = tid + 512 * i; st[i] = *(const v4u*)(DS + (size_t)(u + F.G) * 16384 + (p >> 4) * 128 + (p & 15) * 8); } }
        const int row0 = b * SEQ + c * 64, col = h * 128 + 16 * w + 4 * q4;
        v2u sgw[4];
#pragma unroll
        for (int tb = 0; tb < 4; ++tb) sgw[tb] = *(const v2u*)(SG + (size_t)(row0 + 16 * tb + i16) * 512 + col);
        { const int tb = w & 3, sb0 = 2 * (w >> 2);
          f32x4 a0 = (f32x4){0.f, 0.f, 0.f, 0.f}, a1 = a0;
#pragma unroll
          for (int ks = 0; ks < 4; ++ks) {
              const bf16x8 qb = *(const LAS bf16x8*)(L + LC_QS + (16 * tb + i16) * 272 + (((4 * ks + q4) ^ (2 * tb)) * 16));
              const bf16x8 k0 = *(const LAS bf16x8*)(L + LC_KS + (16 * sb0 + i16) * 272 + (((4 * ks + q4) ^ (2 * sb0)) * 16));
              const bf16x8 k1 = *(const LAS bf16x8*)(L + LC_KS + (16 * (sb0 + 1) + i16) * 272 + (((4 * ks + q4) ^ (2 * (sb0 + 1))) * 16));
              a0 = MFMA16(k0, qb, a0); a1 = MFMA16(k1, qb, a1); }
          const int t = 16 * tb + i16;
#pragma unroll
          for (int r = 0; r < 4; ++r) { if (16 * sb0 + 4 * q4 + r > t) a0[r] = 0.f; if (16 * (sb0 + 1) + 4 * q4 + r > t) a1[r] = 0.f; }
          *(LAS v2u*)(L + LC_P + t * 144 + (16 * sb0 + 4 * q4) * 2) = pk4(a0); *(LAS v2u*)(L + LC_P + t * 144 + (16 * (sb0 + 1) + 4 * q4) * 2) = pk4(a1); }
        __syncthreads();
        f32x4 o[4];
        { bf16x8 av[2], as[4];
#pragma unroll
          for (int ks = 0; ks < 2; ++ks) av[ks] = *(const LAS bf16x8*)(L + LC_VT + (16 * w + i16) * 144 + ks * 64 + q4 * 16);
#pragma unroll
          for (int ks = 0; ks < 4; ++ks) as[ks] = *(const LAS bf16x8*)(L + LC_ST + (16 * w + i16) * 272 + (4 * ks + q4) * 16);
#pragma unroll
          for (int tb = 0; tb < 4; ++tb) {
              f32x4 acc = (f32x4){0.f, 0.f, 0.f, 0.f};
#pragma unroll
              for (int ks = 0; ks < 2; ++ks) if (ks == 0 || tb >= 2) acc = MFMA16(av[ks], *(const LAS bf16x8*)(L + LC_P + (16 * tb + i16) * 144 + ks * 64 + q4 * 16), acc);
#pragma unroll
              for (int ks = 0; ks < 4; ++ks) acc = MFMA16(as[ks], *(const LAS bf16x8*)(L + LC_QS + (16 * tb + i16) * 272 + (((4 * ks + q4) ^ (2 * tb)) * 16)), acc);
              o[tb] = acc;
              float ss = (acc[0] * acc[0] + acc[1] * acc[1]) + (acc[2] * acc[2] + acc[3] * acc[3]);
              ss += __shfl_xor(ss, 16); ss += __shfl_xor(ss, 32);
              if (q4 == 0) *(LAS float*)(L + LC_RED + (w * 64 + 16 * tb + i16) * 4) = ss;
          } }
        __syncthreads();
        const f32x4 gv = *(const f32x4*)(gh + col);
#pragma unroll
        for (int tb = 0; tb < 4; ++tb) {
            float tot = 0.f;
#pragma unroll
            for (int ww = 0; ww < 8; ++ww) tot += *(const LAS float*)(L + LC_RED + (ww * 64 + 16 * tb + i16) * 4);
            const float rr = 1.f / sqrtf(tot * (1.f / DV) + EPS);
            v2u yo; yo.x = pk2(o[tb][0] * rr * gv[0] * bflo(sgw[tb].x), o[tb][1] * rr * gv[1] * bfhi(sgw[tb].x)); yo.y = pk2(o[tb][2] * rr * gv[2] * bflo(sgw[tb].y), o[tb][3] * rr * gv[3] * bfhi(sgw[tb].y));
            *(v2u*)(Y + (size_t)(row0 + 16 * tb + i16) * D + col) = yo;
        }
        __syncthreads();
    }
}


constexpr int ATT_BUF = 36864;
__device__ __forceinline__ void att_stage_load(v4u (&pre)[4], const unsigned char* ws, int b, int h, int st, int tid) {
    if (st < 4) {
        const bf16* KM = (const bf16*)(ws + WS_KM) + (size_t)(b * MEML + 64 * st) * D + h * MHD;
#pragma unroll
        for (int i = 0; i < 4; ++i) { const int p = tid + 512 * i; pre[i] = *(const v4u*)(KM + (size_t)(p >> 5) * D + (p & 31) * 8); }
    } else {
        const int hp = (st - 4) >> 2, vc = (st - 4) & 3;
        const bf16* VMT = (const bf16*)(ws + WS_VMT) + (size_t)(h * MHD + 128 * hp) * MROWS + b * MEML + 64 * vc;
#pragma unroll
        for (int i = 0; i < 2; ++i) { const int p = tid + 512 * i; pre[i] = *(const v4u*)(VMT + (size_t)(p >> 3) * MROWS + (p & 7) * 8); }
    }
}
__device__ __forceinline__ void att_stage_write(const v4u (&pre)[4], LAS unsigned char* buf, int st, int tid) {
    if (st < 4) {
#pragma unroll
        for (int i = 0; i < 4; ++i) { const int p = tid + 512 * i; *(LAS v4u*)(buf + (p >> 5) * 528 + (p & 31) * 16) = pre[i]; }
    } else {
#pragma unroll
        for (int i = 0; i < 2; ++i) { const int p = tid + 512 * i; *(LAS v4u*)(buf + (p >> 3) * 144 + (p & 7) * 16) = pre[i]; }
    }
}
__device__ __forceinline__ void p_attn(const Frame& F) {
    unsigned char* ws = F.ws; const bf16* QM = (const bf16*)(ws + WS_QM); bf16* ATT = (bf16*)(ws + WS_ATT);
    const int tid = F.tid, lane = F.lane, w = F.wave, i16 = lane & 15, q4 = lane >> 4;
    for (int u = F.vcu; u < BATCH * MH * (SEQ / 256); u += F.G) {
        const int tblk = u & 15, h = (u >> 4) & 3, b = u >> 6;
        const int tok0 = b * SEQ + tblk * 256 + 32 * w;
        v4u pre[4];
        att_stage_load(pre, ws, b, h, 0, tid);
        const bf16* qp = QM + (size_t)(tok0 + i16) * D + h * MHD + 8 * q4;
        att_stage_write(pre, F.lds, 0, tid);
        __syncthreads();
        f32x4 S[16][2];
#pragma unroll
        for (int i = 0; i < 16; ++i) { S[i][0] = (f32x4){0.f, 0.f, 0.f, 0.f}; S[i][1] = S[i][0]; }
#pragma unroll
        for (int st = 0; st < 4; ++st) {
            att_stage_load(pre, ws, b, h, st + 1, tid);
            LAS unsigned char* buf = F.lds + (st & 1) * ATT_BUF;
#pragma unroll
            for (int ks = 0; ks < 8; ++ks) {
                const bf16x8 q0 = *(const bf16x8*)(qp + 32 * ks), q1 = *(const bf16x8*)(qp + 16 * D + 32 * ks);
#pragma unroll
                for (int mt = 0; mt < 4; ++mt) {
                    const bf16x8 kf = *(const LAS bf16x8*)(buf + (16 * mt + i16) * 528 + (32 * ks + 8 * q4) * 2);
                    S[4 * st + mt][0] = MFMA16(kf, q0, S[4 * st + mt][0]); S[4 * st + mt][1] = MFMA16(kf, q1, S[4 * st + mt][1]);
                }
            }
            att_stage_write(pre, F.lds + ((st + 1) & 1) * ATT_BUF, st + 1, tid);
            __syncthreads();
        }
        bf16x8 pf[8][2]; float inv[2];
#pragma unroll
        for (int tt = 0; tt < 2; ++tt) {
            float mx = -3.0e38f;
#pragma unroll
            for (int i = 0; i < 16; ++i) mx = fmaxf(mx, fmaxf(fmaxf(S[i][tt][0], S[i][tt][1]), fmaxf(S[i][tt][2], S[i][tt][3])));
            mx = fmaxf(mx, __shfl_xor(mx, 16)); mx = fmaxf(mx, __shfl_xor(mx, 32));
            float l = 0.f;
#pragma unroll
            for (int k2 = 0; k2 < 8; ++k2) {
                float e[8];
#pragma unroll
                for (int r = 0; r < 4; ++r) { e[r] = __expf(S[2 * k2][tt][r] - mx); e[4 + r] = __expf(S[2 * k2 + 1][tt][r] - mx); }
#pragma unroll
                for (int r = 0; r < 8; ++r) l += e[r];
                pf[k2][tt] = __builtin_bit_cast(bf16x8, pack8(e));
            }
            l += __shfl_xor(l, 16); l += __shfl_xor(l, 32);
            inv[tt] = 1.f / l;
        }
#pragma unroll
        for (int hp = 0; hp < 2; ++hp) {
            f32x4 O[8][2];
#pragma unroll
            for (int i = 0; i < 8; ++i) { O[i][0] = (f32x4){0.f, 0.f, 0.f, 0.f}; O[i][1] = O[i][0]; }
#pragma unroll
            for (int vc = 0; vc < 4; ++vc) {
                const int st = 4 + 4 * hp + vc;
                if (st < 11) att_stage_load(pre, ws, b, h, st + 1, tid);
                LAS unsigned char* buf = F.lds + (st & 1) * ATT_BUF;
#pragma unroll
                for (int k2 = 0; k2 < 2; ++k2)
#pragma unroll
                    for (int hdt = 0; hdt < 8; ++hdt) {
                        const bf16x4 lo = *(const LAS bf16x4*)(buf + (16 * hdt + i16) * 144 + (32 * k2 + 4 * q4) * 2), hi = *(const LAS bf16x4*)(buf + (16 * hdt + i16) * 144 + (32 * k2 + 16 + 4 * q4) * 2);
                        const bf16x8 vf = __builtin_shufflevector(lo, hi, 0, 1, 2, 3, 4, 5, 6, 7);
                        O[hdt][0] = MFMA16(vf, pf[2 * vc + k2][0], O[hdt][0]); O[hdt][1] = MFMA16(vf, pf[2 * vc + k2][1], O[hdt][1]);
                    }
                if (st < 11) att_stage_write(pre, F.lds + ((st + 1) & 1) * ATT_BUF, st + 1, tid);
                __syncthreads();
            }
#pragma unroll
            for (int tt = 0; tt < 2; ++tt)
#pragma unroll
                for (int hdt = 0; hdt < 8; ++hdt) {
                    const f32x4 v = O[hdt][tt] * inv[tt];
                    *(v2u*)(ATT + (size_t)(tok0 + 16 * tt + i16) * D + h * MHD + 128 * hp + 16 * hdt + 4 * q4) = pk4(v);
                }
        }
    }
}

__device__ __forceinline__ void p_attn_simple(const Frame& F) {
    const bf16* QM = (const bf16*)(F.ws + WS_QM); const bf16* KM = (const bf16*)(F.ws + WS_KM); const bf16* VMT = (const bf16*)(F.ws + WS_VMT); bf16* ATT = (bf16*)(F.ws + WS_ATT);
    const int lane = F.lane;
    for (int it = F.gw; it < M * MH; it += F.NGW) {
        const int row = it >> 2, h = it & 3, b = row / SEQ;
        const v2u qw = *(const v2u*)(QM + (size_t)row * D + h * MHD + 4 * lane);
        const float q0 = bflo(qw.x), q1 = bfhi(qw.x), q2 = bflo(qw.y), q3 = bfhi(qw.y);
        float sc[4];
#pragma unroll
        for (int jj = 0; jj < 4; ++jj) {
            float mine = 0.f;
            for (int jl = 0; jl < 64; ++jl) {
                const v2u kw = *(const v2u*)(KM + (size_t)(b * MEML + jj * 64 + jl) * D + h * MHD + 4 * lane);
                const float s = wave_sum(q0 * bflo(kw.x) + q1 * bfhi(kw.x) + q2 * bflo(kw.y) + q3 * bfhi(kw.y));
                if (lane == jl) mine = s;
            }
            sc[jj] = mine;
        }
        const float mx = wave_max(fmaxf(fmaxf(sc[0], sc[1]), fmaxf(sc[2], sc[3])));
        float l = 0.f;
#pragma unroll
        for (int jj = 0; jj < 4; ++jj) { sc[jj] = __expf(sc[jj] - mx); l += sc[jj]; }
        const float inv = 1.f / wave_sum(l);
        float acc[4] = {0.f, 0.f, 0.f, 0.f};
#pragma unroll
        for (int jj = 0; jj < 4; ++jj)
            for (int jc = 0; jc < 8; ++jc) {
                float p[8];
#pragma unroll
                for (int e = 0; e < 8; ++e) p[e] = __shfl(sc[jj], jc * 8 + e);
#pragma unroll
                for (int i = 0; i < 4; ++i) { float vv[8]; unpack8(*(const v4u*)(VMT + (size_t)(h * MHD + 4 * lane + i) * MROWS + b * MEML + jj * 64 + jc * 8), vv);
#pragma unroll
                    for (int e = 0; e < 8; ++e) acc[i] += p[e] * vv[e]; }
            }
        v2u o; o.x = pk2(acc[0] * inv, acc[1] * inv); o.y = pk2(acc[2] * inv, acc[3] * inv);
        *(v2u*)(ATT + (size_t)row * D + h * MHD + 4 * lane) = o;
    }
}


#ifndef OPT_SCAN
#define OPT_SCAN 1
#endif
#ifndef OPT_ATTN
#define OPT_ATTN 1
#endif
#ifndef OPT_MASK
#define OPT_MASK 255
#endif
#define GEMM1(bit, multi, Ap, Bp, Mr, Nn, Kk, EmT, emv) GEMM1C(bit, multi, (int)blockIdx.x, Ap, Bp, Mr, Nn, Kk, EmT, emv)
#define GEMM1C(bit, multi, cc, Ap, Bp, Mr, Nn, Kk, EmT, emv) do { if constexpr ((OPT_MASK & (bit)) != 0) { \
        pg8::Sched1 S_{(Ap), (Bp), (Mr) / 256, (Nn) / 256, F.G, (cc)}; pg8::EpiEmit<EmT> E_{emv}; \
        pg8::gemm_phase<pg8::EpiEmit<EmT>, pg8::Sched1, multi, true>(F.lds, (Kk), S_, E_); \
    } else { naive_gemm(F, (Ap), (Bp), (Mr), (Nn), (Kk), emv); } } while (0)

struct Args { const float* in[22]; float* out; unsigned char* ws; int ph_lo, ph_hi; };
__global__ void __launch_bounds__(NTHR, 2) fwd(Args args) {
    extern __shared__ __attribute__((aligned(16))) unsigned char lds[];
    Frame F;
    F.lds = (LAS unsigned char*)lds;
    F.tid = threadIdx.x; F.lane = F.tid & 63; F.wave = __builtin_amdgcn_readfirstlane(F.tid >> 6);
    F.G = gridDim.x; { const int bx = blockIdx.x; F.vcu = (F.G % 8 == 0) ? (bx % 8) * (F.G / 8) + bx / 8 : bx; }
    F.gtid = (long)F.vcu * NTHR + F.tid; F.NT = (long)F.G * NTHR; F.gw = F.vcu * NWAVES + F.wave; F.NGW = F.G * NWAVES;
    F.in = args.in;
    F.out = args.out; F.ws = args.ws;
    unsigned char* ws = args.ws;
    const int lo = args.ph_lo, hi = args.ph_hi;
    for (int u = F.tid; u < (LDS_BYTES - LDSCTL_OFF) / 4; u += NTHR) ((LAS unsigned*)(F.lds + LDSCTL_OFF))[u] = 0u;
    __syncthreads();
    XcdBarrier bar; bar.bar = (unsigned*)(ws + WS_CTL) + CW_BAR; bar.x = 0; bar.st = nullptr;
    if (hi - lo > 1) bar = xcd_barrier_post((unsigned*)(ws + WS_CTL) + CW_BAR, (volatile LAS unsigned*)(F.lds + MISC_OFF) + 8);
#define IN(k) (lo <= (k) && (k) < hi)
#define SEAM(k) do { if (IN(k) && IN((k) + 1)) xcd_barrier(bar); } while (0)
    const float* RS = (const float*)(ws + WS_RS);
    if (IN(0)) p_prologue(F);
    SEAM(0);
    if (IN(1)) {
        GEMM1(1, true, (const bf16*)(ws + WS_XN), (const bf16*)(ws + WS_WGU1), M, NGU, D, EmGU, (EmGU{(bf16*)(ws + WS_HID), nullptr}));
        GEMM1C(1, false, (int)blockIdx.x - 128, (const bf16*)(ws + WS_MN), (const bf16*)(ws + WS_WKV), MROWS, D, D, EmPlain, (EmPlain{(bf16*)(ws + WS_KM), nullptr, 1.f}));
        GEMM1C(1, false, (int)blockIdx.x - 144, (const bf16*)(ws + WS_WKV) + (size_t)D * D, (const bf16*)(ws + WS_MN), D, MROWS, D, EmPlain, (EmPlain{(bf16*)(ws + WS_VMT), nullptr, 1.f}));
    }
    SEAM(1);
    if (IN(2)) GEMM1(2, false, (const bf16*)(ws + WS_HID), (const bf16*)(ws + WS_WD1), M, D, DFF, EmRes, (EmRes{F.in[0], F.out, (bf16*)(ws + WS_XB), 0.5f}));
    SEAM(2);
    if (IN(3)) p_rowstat(F);
    SEAM(3);
    if (IN(4)) {
        GEMM1(4, true, (const bf16*)(ws + WS_XB), (const bf16*)(ws + WS_WIN) + (size_t)1536 * D, M, 2048, D, EmInA, (EmInA{(bf16*)(ws + WS_SG), (bf16*)(ws + WS_ZB), (bf16*)(ws + WS_P), RS}));
        GEMM1(4, true, (const bf16*)(ws + WS_WIN), (const bf16*)(ws + WS_XB), 1536, M, D, EmInB,
              (EmInB{(bf16*)(ws + WS_Q), (bf16*)(ws + WS_KK), (bf16*)(ws + WS_V), (float*)(ws + WS_LOGF), RS, (const float*)(ws + WS_LB)}));
    }
    SEAM(4);
#if OPT_SCAN
    if (IN(5)) { p_conv(F); p_scanA(F); }
    SEAM(5);
    if (IN(6)) p_scanB(F);
    SEAM(6);
    if (IN(7)) p_scanC(F);
#else
    if (IN(5)) { p_conv(F); p_scan_simple(F); }
    SEAM(5);
    if (IN(6)) {}
    SEAM(6);
    if (IN(7)) p_hnorm_simple(F);
#endif
    SEAM(7);
    if (IN(8)) GEMM1(8, false, (const bf16*)(ws + WS_Y), (const bf16*)(ws + WS_WOUT), M, D, D, EmRes, (EmRes{F.out, F.out, (bf16*)(ws + WS_XB2), 1.f}));
    SEAM(8);
    if (IN(9)) p_rowstat(F);
    SEAM(9);
    if (IN(10)) GEMM1(16, false, (const bf16*)(ws + WS_XB2), (const bf16*)(ws + WS_WQ), M, D, D, EmPlain, (EmPlain{(bf16*)(ws + WS_QM), RS, 0.0625f}));
    SEAM(10);
#if OPT_ATTN
    if (IN(11)) p_attn(F);
#else
    if (IN(11)) p_attn_simple(F);
#endif
    SEAM(11);
    if (IN(12)) GEMM1(32, false, (const bf16*)(ws + WS_ATT), (const bf16*)(ws + WS_WO), M, D, D, EmRes, (EmRes{F.out, F.out, (bf16*)(ws + WS_XB2), 1.f}));
    SEAM(12);
    if (IN(13)) p_rowstat(F);
    SEAM(13);
    if (IN(14)) GEMM1(64, true, (const bf16*)(ws + WS_XB2), (const bf16*)(ws + WS_WGU2), M, NGU, D, EmGU, (EmGU{(bf16*)(ws + WS_HID), RS}));
    SEAM(14);
    if (IN(15)) GEMM1(128, false, (const bf16*)(ws + WS_HID), (const bf16*)(ws + WS_WD2), M, D, DFF, EmRes, (EmRes{F.out, F.out, nullptr, 0.5f}));
    SEAM(15);
    if (IN(16)) p_final(F);
#undef IN
#undef SEAM
}

extern "C" void kernel_launch(void* const* d_in, const int* in_sizes, int n_in, void* d_out, int out_size, void* d_ws, size_t ws_size, hipStream_t stream) {
    static int grid = 0;
    if (grid == 0) {
        if (n_in != 22 || in_sizes[0] != M * D || out_size != M * D || ws_size < WS_END) { fprintf(stderr, "kernel_launch: unexpected shapes (n_in %d, in0 %d, out %d, ws %zu)\n", n_in, n_in > 0 ? in_sizes[0] : -1, out_size, ws_size); grid = -1; return; }
        int dev = 0, cus = 0;
        if (hipGetDevice(&dev) != hipSuccess || hipDeviceGetAttribute(&cus, hipDeviceAttributeMultiprocessorCount, dev) != hipSuccess) { grid = -1; return; }
        if (hipFuncSetAttribute((const void*)fwd, hipFuncAttributeMaxDynamicSharedMemorySize, LDS_BYTES) != hipSuccess) { fprintf(stderr, "kernel_launch: hipFuncSetAttribute failed\n"); grid = -1; return; }
        grid = cus;
    }
    if (grid < 0) return;
    Args a{};
    for (int i = 0; i < 22; ++i) a.in[i] = (const float*)d_in[i];
    a.out = (float*)d_out; a.ws = (unsigned char*)d_ws;
    if (hipMemsetAsync((char*)d_ws + WS_CTL, 0, CTL_ZERO_BYTES, stream) != hipSuccess) { fprintf(stderr, "kernel_launch: memset failed\n"); return; }
    a.ph_lo = 0; a.ph_hi = NPHASE;
    void* kargs[] = {&a};
    hipError_t e = hipLaunchCooperativeKernel((const void*)fwd, dim3(grid), dim3(NTHR), kargs, LDS_BYTES, stream);
    if (e != hipSuccess) fprintf(stderr, "kernel_launch: cooperative launch failed: %s (grid %d)\n", hipGetErrorString(e), grid);
}
```

```cpp
#include <hip/hip_runtime.h>
#include <cstdio>
#include <cstdint>

#define GAS __attribute__((address_space(1)))
#define LAS __attribute__((address_space(3)))
typedef unsigned short bf16;
typedef unsigned v4u __attribute__((ext_vector_type(4)));
typedef unsigned v2u __attribute__((ext_vector_type(2)));
typedef float f32x4 __attribute__((ext_vector_type(4)));

constexpr int BATCH = 4, SEQ = 4096, D = 1024, M = BATCH * SEQ, DFF = 2816, NGU = 2 * DFF, INC = 3584;
constexpr int HF = 512, NH = 4, DK = 128, DV = 128, CHUNK = 64, NCHUNK = SEQ / CHUNK;
constexpr int MEML = 256, MH = 4, MHD = 256, MROWS = BATCH * MEML;
constexpr float EPS = 1e-6f;
constexpr int NWAVES = 8, NTHR = NWAVES * 64;
constexpr int NPHASE = 14;

constexpr size_t MiB = 1u << 20;
constexpr size_t WS_CTL = 0, CTL_ZERO_BYTES = 1 * MiB;
constexpr size_t WS_LB = 1 * MiB, WS_RS = 1 * MiB + 65536;
constexpr size_t WS_WGU1 = 2 * MiB, WS_WD1 = 13 * MiB, WS_WIN = WS_WD1 + 5 * MiB + 512 * 1024, WS_WOUT = WS_WIN + 7 * MiB, WS_WQ = WS_WOUT + 2 * MiB,
                 WS_WKV = WS_WQ + 2 * MiB, WS_WO = WS_WKV + 4 * MiB, WS_WGU2 = WS_WO + 2 * MiB, WS_WD2 = WS_WGU2 + 11 * MiB, WS_MN = 52 * MiB, WS_KM = 54 * MiB, WS_VMT = 56 * MiB,
                 WS_DEC = 58 * MiB, WS_RSP = 59 * MiB;
static_assert(WS_WD2 + 5 * MiB + 512 * 1024 == WS_MN, "weight map");
constexpr size_t WS_XN = 64 * MiB, WS_HID = 96 * MiB, WS_XB = 216 * MiB;
constexpr size_t WS_Q = 64 * MiB, WS_KK = 80 * MiB, WS_LOGF = 96 * MiB, WS_V = 128 * MiB, WS_SG = 144 * MiB, WS_ZB = 160 * MiB, WS_P = 176 * MiB, WS_DS = 192 * MiB, WS_Y = 224 * MiB;
constexpr size_t WS_XB2 = 64 * MiB, WS_QM = 96 * MiB, WS_ATT = 128 * MiB, WS_END = 256 * MiB;

constexpr int RING_BYTES = 131072, LDSCTL_OFF = RING_BYTES, MISC_OFF = LDSCTL_OFF + 320, LDS_BYTES = 147456;

__device__ __forceinline__ unsigned f2bf(float f) { unsigned u = __builtin_bit_cast(unsigned, f); return (u + 0x7fffu + ((u >> 16) & 1u)) >> 16; }
__device__ __forceinline__ unsigned pk2(float lo, float hi) { return f2bf(lo) | (f2bf(hi) << 16); }
__device__ __forceinline__ float bflo(unsigned w) { return __builtin_bit_cast(float, w << 16); }
__device__ __forceinline__ float bfhi(unsigned w) { return __builtin_bit_cast(float, w & 0xffff0000u); }
__device__ __forceinline__ float bf2f(bf16 b) { return __builtin_bit_cast(float, (unsigned)b << 16); }
__device__ __forceinline__ float wave_sum(float v) {
#pragma unroll
    for (int o = 1; o < 64; o <<= 1) v += __shfl_xor(v, o);
    return v;
}
__device__ __forceinline__ float wave_max(float v) {
#pragma unroll
    for (int o = 1; o < 64; o <<= 1) v = fmaxf(v, __shfl_xor(v, o));
    return v;
}
__device__ __forceinline__ float silu_f(float x) { return x / (1.f + __expf(-x)); }
__device__ __forceinline__ float sigm_f(float x) { return 1.f / (1.f + __expf(-x)); }
__device__ __forceinline__ void unpack8(v4u w, float (&f)[8]) {
    f[0] = bflo(w.x); f[1] = bfhi(w.x); f[2] = bflo(w.y); f[3] = bfhi(w.y); f[4] = bflo(w.z); f[5] = bfhi(w.z); f[6] = bflo(w.w); f[7] = bfhi(w.w);
}
__device__ __forceinline__ v4u pack8(const float (&f)[8]) { v4u w; w.x = pk2(f[0], f[1]); w.y = pk2(f[2], f[3]); w.z = pk2(f[4], f[5]); w.w = pk2(f[6], f[7]); return w; }


typedef GAS unsigned gu32;
constexpr int CW_TMO = 0, CW_CODE = 1, CW_BAR = 4096;
#define XB_TMO      128
#define XB_XCNT(j)  (256  + 64 * (j))
#define XB_XSUB(j)  (1280 + 64 * (j))
#define XB_XGEN(j)  (2304 + 64 * (j))
#define XB_TOP      3328
#define XB_TOPGEN   3392
#define XCD_BAR_WORDS 3456
#define XB_SPIN_CAP (1u << 18)
__device__ __forceinline__ unsigned xb_ld(unsigned* p)              { return __hip_atomic_load(p, __ATOMIC_RELAXED, __HIP_MEMORY_SCOPE_AGENT); }
__device__ __forceinline__ unsigned xb_add(unsigned* p, unsigned v) { return __hip_atomic_fetch_add(p, v, __ATOMIC_RELAXED, __HIP_MEMORY_SCOPE_AGENT); }
__device__ __forceinline__ unsigned xb_xcc_id() { return (unsigned)__builtin_amdgcn_s_getreg((3 << 11) | 20) & 0xFu; }
#define XB_SPIN(cond, bar) do { unsigned _sp = 0; while (cond) { __builtin_amdgcn_s_sleep(1); \
    if ((++_sp & 255u) == 0u) { if (xb_ld(&(bar)[XB_TMO])) break; if (_sp > XB_SPIN_CAP) { atomicAdd(&(bar)[XB_TMO], 1u); break; } } } } while (0)
struct XcdBarrier { unsigned* bar; unsigned x; volatile LAS unsigned* st; };
__device__ __forceinline__ XcdBarrier xcd_barrier_post(unsigned* bar, volatile LAS unsigned* st) {
    XcdBarrier b; b.bar = bar; b.x = xb_xcc_id(); b.st = st;
    if (threadIdx.x == 0) (void)xb_add(&bar[XB_XCNT(b.x)], 1u);
    return b;
}
__device__ __forceinline__ void xcd_barrier_complete(unsigned* bar, unsigned x, unsigned& nloc, unsigned& nx) {
    const unsigned G = gridDim.x * gridDim.y * gridDim.z;
    unsigned sum, cnt, mine, sp = 0u;
    for (;;) {
        sum = 0u; cnt = 0u; mine = 0u;
#pragma unroll
        for (unsigned j = 0; j < 16; ++j) { const unsigned c = xb_ld(&bar[XB_XCNT(j)]); sum += c; cnt += (c > 0u) ? 1u : 0u; mine = (j == x) ? c : mine; }
        if (sum == G) break;
        __builtin_amdgcn_s_sleep(1);
        if ((++sp & 255u) == 0u) { if (xb_ld(&bar[XB_TMO])) break; if (sp > XB_SPIN_CAP) { atomicAdd(&bar[XB_TMO], 1u); break; } }
    }
    nloc = mine > 0u ? mine : 1u; nx = cnt > 0u ? cnt : 1u;
}
__device__ __forceinline__ void xcd_barrier(const XcdBarrier& b) {
    asm volatile("s_waitcnt vmcnt(0)" ::: "memory");
    __syncthreads();
    if (threadIdx.x == 0) {
        unsigned* bar = b.bar;
        __builtin_amdgcn_s_waitcnt(0);
        unsigned nloc = b.st[0], nx = b.st[1];
        if (nloc == 0u) { xcd_barrier_complete(bar, b.x, nloc, nx); b.st[0] = nloc; b.st[1] = nx; }
        const unsigned old = xb_add(&bar[XB_XSUB(b.x)], 1u);
        const unsigned gen = old / nloc;
        if (old + 1u == (gen + 1u) * nloc) {
            __builtin_amdgcn_fence(__ATOMIC_RELEASE, "agent");
            asm volatile("s_waitcnt vmcnt(0)" ::: "memory");
            const unsigned og = xb_add(&bar[XB_TOP], 1u);
            const unsigned tg = og / nx;
            if (og + 1u == (tg + 1u) * nx) xb_add(&bar[XB_TOPGEN], 1u);
            else XB_SPIN(xb_ld(&bar[XB_TOPGEN]) == tg, bar);
            __builtin_amdgcn_fence(__ATOMIC_ACQUIRE, "agent");
            xb_add(&bar[XB_XGEN(b.x)], 1u);
            asm volatile("s_waitcnt vmcnt(0)" ::: "memory");
        } else {
            XB_SPIN(xb_ld(&bar[XB_XGEN(b.x)]) == gen, bar);
            __builtin_amdgcn_fence(__ATOMIC_ACQUIRE, "agent");
            asm volatile("s_waitcnt vmcnt(0)" ::: "memory");
        }
    }
    __syncthreads();
}

struct Frame {
    LAS unsigned char* lds;
    int tid, lane, wave, vcu, G;
    long gtid, NT;
    int gw, NGW;
    const float* const* in; float* out; unsigned char* ws;
};

struct EmGU {
    bf16* HID;
    __device__ __forceinline__ void operator()(int row, int pn, int c8, const float (&a)[8], const float (&b)[8], float r) const {
        float h[8];
#pragma unroll
        for (int j = 0; j < 8; ++j) h[j] = silu_f(r * a[j]) * (r * b[j]);
        *(v4u*)(HID + (size_t)row * DFF + 128 * pn + c8) = pack8(h);
    }
};
struct EmRes {
    const float* XIN; float* XF; bf16* XB; float scale;
    __device__ __forceinline__ float operator()(int row, int pn, int c8, const float (&a)[8], const float (&b)[8]) const {
        float ss = 0.f;
#pragma unroll
        for (int hh = 0; hh < 2; ++hh) {
            const size_t off = (size_t)row * D + 256 * pn + 128 * hh + c8;
            const f32x4 x0 = *(const f32x4*)(XIN + off), x1 = *(const f32x4*)(XIN + off + 4);
            float o[8];
#pragma unroll
            for (int j = 0; j < 4; ++j) { o[j] = x0[j] + scale * (hh ? b[j] : a[j]); o[4 + j] = x1[j] + scale * (hh ? b[4 + j] : a[4 + j]); }
#pragma unroll
            for (int j = 0; j < 8; ++j) ss += o[j] * o[j];
            *(f32x4*)(XF + off) = (f32x4){o[0], o[1], o[2], o[3]}; *(f32x4*)(XF + off + 4) = (f32x4){o[4], o[5], o[6], o[7]};
            if (XB) *(v4u*)(XB + off) = pack8(o);
        }
        return ss;
    }
};
struct EmInA {
    bf16 *SG, *ZB, *P;
    __device__ __forceinline__ void operator()(int row, int pn, int c8, const float (&a)[8], const float (&b)[8], float r) const {
        if (pn >= 4) {
            float o[8];
#pragma unroll
            for (int j = 0; j < 8; ++j) o[j] = (r * a[j]) * (r * b[j]);
            *(v4u*)(P + (size_t)row * 512 + 128 * (pn - 4) + c8) = pack8(o);
            return;
        }
#pragma unroll
        for (int hh = 0; hh < 2; ++hh) {
            const size_t off = (size_t)row * 512 + 256 * (pn & 1) + 128 * hh + c8;
            float z[8];
#pragma unroll
            for (int j = 0; j < 8; ++j) z[j] = r * (hh ? b[j] : a[j]);
            if (pn < 2) {
#pragma unroll
                for (int j = 0; j < 8; ++j) z[j] = silu_f(z[j]);
                *(v4u*)(SG + off) = pack8(z);
            } else *(v4u*)(ZB + off) = pack8(z);
        }
    }
};
struct EmInB {
    bf16 *QT, *KT, *VT; float* LOGFT; const float* LB;
    __device__ __forceinline__ void operator()(int row, int pn, int c8, const float (&a)[8], const float (&b)[8], const float (&r0)[8], const float (&r1)[8]) const {
        const int kind = row >> 9, ch = row & 511;
        const float lb = LB[ch];
#pragma unroll
        for (int hh = 0; hh < 2; ++hh) {
            const int tok = 256 * pn + 128 * hh + c8; const size_t off = (size_t)ch * M + tok;
            float z[8], o[8];
#pragma unroll
            for (int j = 0; j < 8; ++j) z[j] = hh ? r1[j] * b[j] : r0[j] * a[j];
            if (kind == 0) {
#pragma unroll
                for (int j = 0; j < 8; ++j) o[j] = silu_f(z[j]) * 0.08838834764831845f;
                *(v4u*)(QT + off) = pack8(o);
            } else if (kind == 1) {
                float lf[8];
#pragma unroll
                for (int j = 0; j < 8; ++j) { const float f = lb + (1.f - lb) * sigm_f(z[j]); o[j] = 1.f - f; lf[j] = __logf(f); }
                *(v4u*)(KT + off) = pack8(o);
                *(f32x4*)(LOGFT + off) = (f32x4){lf[0], lf[1], lf[2], lf[3]}; *(f32x4*)(LOGFT + off + 4) = (f32x4){lf[4], lf[5], lf[6], lf[7]};
            } else *(v4u*)(VT + off) = pack8(z);
        }
    }
};
struct EmPlain {
    bf16* O; float scale;
    __device__ __forceinline__ void operator()(int row, int pn, int c8, const float (&a)[8], const float (&b)[8], float r) const {
        const float rs = r * scale; float o[8];
#pragma unroll
        for (int j = 0; j < 8; ++j) o[j] = rs * a[j];
        *(v4u*)(O + (size_t)row * 1024 + 256 * pn + c8) = pack8(o);
#pragma unroll
        for (int j = 0; j < 8; ++j) o[j] = rs * b[j];
        *(v4u*)(O + (size_t)row * 1024 + 256 * pn + 128 + c8) = pack8(o);
    }
};

namespace pg8 {
#define PG8_LAS __attribute__((address_space(3)))
typedef unsigned short bf16_t;
typedef short bf16x8 __attribute__((ext_vector_type(8)));
typedef unsigned u32x4 __attribute__((ext_vector_type(4)));
constexpr int BM = 256, BK = 64, HALF = 128, HTB = HALF * BK * 2, STAGE_BYTES = 8 * HTB, NXCD = 8, WGM = 8;
__host__ __device__ __forceinline__ int lds_byte(int r, int c) { const int st = (r >> 4) * 2 + (c >> 5), rr = r & 15, cc = c & 31, ob = rr * 64 + cc * 2; return st * 1024 + (ob ^ (((ob >> 9) & 1) << 5)); }
__host__ __device__ __forceinline__ void stage_rc(int b, int& R, int& C) { const int st = b / 1024, sb = b % 1024, swz = sb ^ (((sb >> 9) & 1) << 5); R = (st >> 1) * 16 + swz / 64; C = (st & 1) * 32 + (swz % 64) / 2; }
__host__ __device__ __forceinline__ int perm32(int rho) { const int n = rho >> 4, i = rho & 15; return 8 * (i >> 2) + 4 * n + (i & 3); }
struct Unit { int pm, pn, gid; };
__device__ __forceinline__ void order_map(int L, int nM, int nN, Unit& u) {
    const int nwg = nM * nN; int wgid = L; { const int q = nwg / NXCD, r = nwg % NXCD, xcd = wgid % NXCD, off = wgid / NXCD; wgid = (xcd < r ? xcd * (q + 1) : r * (q + 1) + (xcd - r) * q) + off; }
    const int nig = WGM * nN, gid = wgid / nig, fm = gid * WGM, gsz = (nM - fm) < WGM ? (nM - fm) : WGM;
    u.pm = fm + ((wgid % nig) % gsz); u.pn = (wgid % nig) / gsz;
}
struct Sched1 {
    const bf16_t* A; const bf16_t* Bt; int nM, nN, G, c;
    __device__ __forceinline__ bool next(int i, Unit& u) const { const long L = (long)i * G + c; if (c < 0 || L >= (long)nM * nN) return false; order_map((int)L, nM, nN, u); u.gid = 0; return true; }
    __device__ __forceinline__ const char* tileA(const Unit& u, size_t tstep) const { return (const char*)A + (size_t)u.pm * tstep; }
    __device__ __forceinline__ const char* tileB(const Unit& u, size_t tstep) const { return (const char*)Bt + (size_t)u.pn * tstep; }
    __device__ __forceinline__ void a_ready(const Unit&) const {}
    __device__ __forceinline__ void done(const Unit&) const {}
};
template <class Emit, int RMODE> struct EpiEmit {
    static constexpr bool PERM = true, AFTER_DRAIN = false; Emit E; float* RSP;
    __device__ __forceinline__ void operator()(const f32x4 (&acc)[2][2][4][2], const Unit& u, int wr, int wc, int fr, int fq) const {
        float r0[8], r1[8];
        if constexpr (RMODE == 2) {
            const int tok = u.pn * BM + 128 * (fr >> 3) + wc * 32 + fq * 8 + (fr & 7);
            const f32x4 p0 = *(const f32x4*)(RSP + (size_t)tok * 16), p1 = *(const f32x4*)(RSP + (size_t)tok * 16 + 4), p2 = *(const f32x4*)(RSP + (size_t)tok * 16 + 8), p3 = *(const f32x4*)(RSP + (size_t)tok * 16 + 12);
            const f32x4 ps = (p0 + p1) + (p2 + p3);
            const float r = 1.f / sqrtf(((ps[0] + ps[1]) + (ps[2] + ps[3])) * (1.f / D) + EPS);
            const int lb = (fq << 4);
#pragma unroll
            for (int j = 0; j < 8; ++j) { r0[j] = __shfl(r, lb + j); r1[j] = __shfl(r, lb + 8 + j); }
        }
#pragma unroll
        for (int ai = 0; ai < 2; ++ai)
#pragma unroll
            for (int m = 0; m < 4; ++m) {
                const int row = u.pm * BM + ai * HALF + wr * 64 + m * 16 + fr, c8 = wc * 32 + fq * 8;
                float a[8], b[8];
#pragma unroll
                for (int j = 0; j < 8; ++j) { a[j] = acc[ai][0][m][j >> 2][j & 3]; b[j] = acc[ai][1][m][j >> 2][j & 3]; }
                if constexpr (RMODE == 0) E(row, u.pn, c8, a, b, 1.f);
                else if constexpr (RMODE == 1) {
                    const f32x4 p = *(const f32x4*)(RSP + (size_t)row * 16 + 4 * fq);
                    float ss = (p[0] + p[1]) + (p[2] + p[3]); ss += __shfl_xor(ss, 16); ss += __shfl_xor(ss, 32);
                    E(row, u.pn, c8, a, b, 1.f / sqrtf(ss * (1.f / D) + EPS));
                } else if constexpr (RMODE == 2) E(row, u.pn, c8, a, b, r0, r1);
                else {
                    float ss = E(row, u.pn, c8, a, b); ss += __shfl_xor(ss, 16); ss += __shfl_xor(ss, 32);
                    if (RSP && fq == 0) RSP[(size_t)row * 16 + u.pn * 4 + wc] = ss;
                }
            }
    }
};
template <class Epi, class Sched, bool ALIGN_EPI = false, bool SP2 = false>
__device__ __forceinline__ void gemm_phase(PG8_LAS unsigned char* lds, const int K, const Sched& S, const Epi& E) {
    const int tid = threadIdx.x, wid = __builtin_amdgcn_readfirstlane(tid >> 6), lane = tid & 63, wr = wid >> 2, wc = wid & 3, fr = lane & 15, fq = lane >> 4;
    const int nt = K / BK;
    unsigned voffA[2], voffB[2];
#pragma unroll
    for (int i = 0; i < 2; ++i) { int R, C; stage_rc(tid * 16 + i * 8192, R, C); const int Rb = Epi::PERM ? ((R & ~31) + perm32(R & 31)) : R;
        voffA[i] = (unsigned)(R * K + C) * 2u; voffB[i] = (unsigned)(Rb * K + C) * 2u; }
    const size_t kstep = (size_t)(BK * 2);
    const size_t hstep = (size_t)HALF * K * 2;
    const size_t tstep = 2 * hstep;
    const unsigned ldsw = (unsigned)wid * 1024u;
    const int aoff = lds_byte(wr * 64 + fr, fq * 8), boff = lds_byte(wc * 32 + fr, fq * 8);
#define PG8_SA(b, h) (((b) * 2 + (h)) * HTB)
#define PG8_SB(b, h) ((4 + (b) * 2 + (h)) * HTB)
#define PG8_STAGE(bufoff, gbase, voff) do { _Pragma("unroll") for (int _i = 0; _i < 2; ++_i) \
        __builtin_amdgcn_global_load_lds((const unsigned*)((const char*)(gbase) + (voff)[_i]), (PG8_LAS unsigned*)(lds + (bufoff) + ldsw + _i * 8192), 16, 0, 0); } while (0)
#define PG8_LDA(dst, b, h) do { _Pragma("unroll") for (int m = 0; m < 4; ++m) _Pragma("unroll") for (int k = 0; k < 2; ++k) dst[m][k] = *(const PG8_LAS bf16x8*)(lds + PG8_SA(b, h) + aoff + m * 2048 + k * 1024); } while (0)
#define PG8_LDB(dst, b, h) do { _Pragma("unroll") for (int n = 0; n < 2; ++n) _Pragma("unroll") for (int k = 0; k < 2; ++k) dst[n][k] = *(const PG8_LAS bf16x8*)(lds + PG8_SB(b, h) + boff + n * 2048 + k * 1024); } while (0)
#define PG8_MMA(ai, bj, At, Bt) do { __builtin_amdgcn_s_setprio(1); _Pragma("unroll") for (int m = 0; m < 4; ++m) _Pragma("unroll") for (int n = 0; n < 2; ++n) _Pragma("unroll") for (int k = 0; k < 2; ++k) \
        acc[ai][bj][m][n] = __builtin_amdgcn_mfma_f32_16x16x32_bf16(Bt[n][k], At[m][k], acc[ai][bj][m][n], 0, 0, 0); __builtin_amdgcn_s_setprio(0); } while (0)
#define PG8_WAIT_V(n) asm volatile("s_waitcnt vmcnt(" #n ")" ::: "memory")
#define PG8_WAIT_L(n) asm volatile("s_waitcnt lgkmcnt(" #n ")" ::: "memory")
#define PG8_BAR __builtin_amdgcn_s_barrier()
#define PG8_SCHED __builtin_amdgcn_sched_barrier(0)
    Unit cur, nxt; int ui = 0;
    if (!S.next(0, cur)) return;
    f32x4 acc[2][2][4][2];
#pragma unroll
    for (int a = 0; a < 2; ++a)
#pragma unroll
        for (int b = 0; b < 2; ++b)
#pragma unroll
            for (int m = 0; m < 4; ++m)
#pragma unroll
                for (int n = 0; n < 2; ++n) acc[a][b][m][n] = (f32x4){0.f, 0.f, 0.f, 0.f};
    bf16x8 At[4][2], B0[2][2], B1[2][2];
    const char* cA = S.tileA(cur, tstep); const char* cB = S.tileB(cur, tstep);
    S.a_ready(cur);
    if constexpr (SP2) {
        PG8_STAGE(PG8_SB(0, 0), cB, voffB); PG8_STAGE(PG8_SB(0, 1), cB + hstep, voffB); PG8_STAGE(PG8_SA(0, 0), cA, voffA); PG8_STAGE(PG8_SA(0, 1), cA + hstep, voffA);
        if (wr == 1) PG8_BAR;
        PG8_WAIT_V(2); PG8_BAR;
        PG8_STAGE(PG8_SB(1, 0), cB + kstep, voffB); PG8_STAGE(PG8_SA(1, 0), cA + kstep, voffA); PG8_STAGE(PG8_SB(1, 1), cB + hstep + kstep, voffB);
        PG8_WAIT_V(6); PG8_BAR;
    } else {
        PG8_STAGE(PG8_SB(0, 0), cB, voffB); PG8_STAGE(PG8_SA(0, 0), cA, voffA); PG8_STAGE(PG8_SB(0, 1), cB + hstep, voffB); PG8_STAGE(PG8_SA(0, 1), cA + hstep, voffA);
        if (wr == 1) PG8_BAR;
        PG8_WAIT_V(4); PG8_BAR;
        PG8_STAGE(PG8_SB(1, 0), cB + kstep, voffB); PG8_STAGE(PG8_SA(1, 0), cA + kstep, voffA); PG8_STAGE(PG8_SB(1, 1), cB + hstep + kstep, voffB);
        PG8_WAIT_V(6); PG8_BAR;
    }
    for (;;) {
        const bool has_next = S.next(ui + 1, nxt);
        const char* nA = has_next ? S.tileA(nxt, tstep) : cA; const char* nB = has_next ? S.tileB(nxt, tstep) : cB;
        for (int t = 0; t < nt; t += 2) {
            const bool last = (t == nt - 2);
            const char* a1 = cA + (size_t)(t + 1) * kstep;
            const char* a2 = last ? nA : cA + (size_t)(t + 2) * kstep; const char* b2 = last ? nB : cB + (size_t)(t + 2) * kstep;
            const char* a3 = a2 + kstep; const char* b3 = b2 + kstep;
            if (last && has_next) S.a_ready(nxt);
            if constexpr (SP2) {
            PG8_LDB(B0, 0, 0); PG8_LDB(B1, 0, 1); PG8_SCHED; PG8_LDA(At, 0, 0); PG8_STAGE(PG8_SA(1, 1), a1 + hstep, voffA);
            PG8_WAIT_V(8); PG8_WAIT_L(0); PG8_BAR; PG8_MMA(0, 0, At, B0); PG8_MMA(0, 1, At, B1); PG8_BAR; PG8_SCHED;
            PG8_LDA(At, 0, 1); PG8_STAGE(PG8_SB(0, 0), b2, voffB); PG8_STAGE(PG8_SB(0, 1), b2 + hstep, voffB); PG8_STAGE(PG8_SA(0, 0), a2, voffA);
            PG8_WAIT_V(8); PG8_WAIT_L(0); PG8_BAR; PG8_MMA(1, 0, At, B0); PG8_MMA(1, 1, At, B1); PG8_BAR; PG8_SCHED;
            PG8_LDB(B0, 1, 0); PG8_LDB(B1, 1, 1); PG8_SCHED; PG8_LDA(At, 1, 0); PG8_STAGE(PG8_SA(0, 1), a2 + hstep, voffA);
            PG8_WAIT_V(8); PG8_WAIT_L(0); PG8_BAR; PG8_MMA(0, 0, At, B0); PG8_MMA(0, 1, At, B1); PG8_BAR; PG8_SCHED;
            PG8_LDA(At, 1, 1); PG8_STAGE(PG8_SB(1, 0), b3, voffB); PG8_STAGE(PG8_SB(1, 1), b3 + hstep, voffB); PG8_STAGE(PG8_SA(1, 0), a3, voffA);
            PG8_WAIT_V(8); PG8_WAIT_L(0); PG8_BAR; PG8_MMA(1, 0, At, B0); PG8_MMA(1, 1, At, B1); PG8_BAR; PG8_SCHED;
            } else {
            PG8_LDB(B0, 0, 0); PG8_SCHED; PG8_LDA(At, 0, 0); PG8_STAGE(PG8_SA(1, 1), a1 + hstep, voffA);
            PG8_WAIT_L(8); PG8_BAR; PG8_WAIT_L(0); PG8_MMA(0, 0, At, B0); PG8_BAR; PG8_SCHED;
            PG8_LDB(B1, 0, 1); PG8_STAGE(PG8_SB(0, 0), b2, voffB);
            PG8_BAR; PG8_WAIT_L(0); PG8_MMA(0, 1, At, B1); PG8_BAR;
            PG8_LDA(At, 0, 1); PG8_STAGE(PG8_SA(0, 0), a2, voffA);
            PG8_BAR; PG8_WAIT_L(0); PG8_MMA(1, 0, At, B0); PG8_BAR; PG8_SCHED;
            PG8_STAGE(PG8_SB(0, 1), b2 + hstep, voffB);
            PG8_WAIT_V(6); PG8_BAR; PG8_MMA(1, 1, At, B1); PG8_BAR;
            PG8_LDB(B0, 1, 0); PG8_SCHED; PG8_LDA(At, 1, 0); PG8_STAGE(PG8_SA(0, 1), a2 + hstep, voffA);
            PG8_WAIT_L(8); PG8_BAR; PG8_WAIT_L(0); PG8_MMA(0, 0, At, B0); PG8_BAR; PG8_SCHED;
            PG8_LDB(B1, 1, 1); PG8_STAGE(PG8_SB(1, 0), b3, voffB);
            PG8_BAR; PG8_WAIT_L(0); PG8_MMA(0, 1, At, B1); PG8_BAR;
            PG8_LDA(At, 1, 1); PG8_STAGE(PG8_SA(1, 0), a3, voffA);
            PG8_BAR; PG8_WAIT_L(0); PG8_MMA(1, 0, At, B0); PG8_BAR; PG8_SCHED;
            PG8_STAGE(PG8_SB(1, 1), b3 + hstep, voffB);
            PG8_WAIT_V(6); PG8_BAR; PG8_MMA(1, 1, At, B1); PG8_BAR;
            }
        }
        if constexpr (ALIGN_EPI) { if (wr == 0) PG8_BAR; }
        if constexpr (!Epi::AFTER_DRAIN) { E(acc, cur, wr, wc, fr, fq); S.done(cur); }
        if (!has_next) break;
#pragma unroll
        for (int a = 0; a < 2; ++a)
#pragma unroll
            for (int b = 0; b < 2; ++b)
#pragma unroll
                for (int m = 0; m < 4; ++m)
#pragma unroll
                    for (int n = 0; n < 2; ++n) acc[a][b][m][n] = (f32x4){0.f, 0.f, 0.f, 0.f};
        cur = nxt; cA = nA; cB = nB; ++ui;
        if constexpr (ALIGN_EPI) { if (wr == 1) PG8_BAR; }
    }
    PG8_WAIT_V(0);
    if constexpr (!ALIGN_EPI) { if (wr == 0) PG8_BAR; }
    PG8_BAR;
    if constexpr (Epi::AFTER_DRAIN) { E.fused(acc, cur, wr, wc, fr, fq, lds, wid, lane); S.done(cur); }
#undef PG8_SA
#undef PG8_SB
#undef PG8_STAGE
#undef PG8_LDA
#undef PG8_LDB
#undef PG8_MMA
#undef PG8_WAIT_V
#undef PG8_WAIT_L
#undef PG8_BAR
#undef PG8_SCHED
}
}

__device__ __forceinline__ void transpose_item(const float* W, int ldw, int col0, const float* g, bf16* WT, int Kd, int n0, int k0, LAS float* scr, int lane) {
#pragma unroll 8
    for (int i = 0; i < 32; ++i) { const int kk = 2 * i + (lane >> 5); const float gv = g ? g[k0 + kk] : 1.f; scr[kk * 33 + (lane & 31)] = W[(size_t)(k0 + kk) * ldw + col0 + (lane & 31)] * gv; }
    asm volatile("s_waitcnt lgkmcnt(0)" ::: "memory");
    const int c = lane & 7;
#pragma unroll
    for (int j = 0; j < 4; ++j) { const int n = (lane >> 3) + 8 * j; const LAS float* s = scr + (8 * c) * 33 + n;
        v4u o; o.x = pk2(s[0 * 33], s[1 * 33]); o.y = pk2(s[2 * 33], s[3 * 33]); o.z = pk2(s[4 * 33], s[5 * 33]); o.w = pk2(s[6 * 33], s[7 * 33]);
        *(v4u*)(WT + (size_t)(n0 + n) * Kd + k0 + 8 * c) = o; }
    asm volatile("s_waitcnt lgkmcnt(0)" ::: "memory");
}
__device__ __forceinline__ void norm_row_bf16(const float* xrow, const float* gain, bf16* orow, int lane) {
    const f32x4* xr = (const f32x4*)xrow + lane; f32x4 v[4]; float s = 0.f;
#pragma unroll
    for (int j = 0; j < 4; ++j) { v[j] = xr[64 * j]; s += (v[j].x * v[j].x + v[j].y * v[j].y) + (v[j].z * v[j].z + v[j].w * v[j].w); }
    const float r = 1.f / sqrtf(wave_sum(s) * (1.f / D) + EPS);
    v2u* o8 = (v2u*)orow + lane;
#pragma unroll
    for (int j = 0; j < 4; ++j) { f32x4 gg = gain ? ((const f32x4*)gain)[lane + 64 * j] : (f32x4){1.f, 1.f, 1.f, 1.f};
        v2u w; w.x = pk2(v[j].x * r * gg.x, v[j].y * r * gg.y); w.y = pk2(v[j].z * r * gg.z, v[j].w * r * gg.w); o8[64 * j] = w; }
}
__device__ __forceinline__ void p_prologue(const Frame& F) {
    LAS float* scr = (LAS float*)(F.lds + F.wave * 16384);
    unsigned char* ws = F.ws;
    constexpr int I_GU = 16 * (NGU / 32), I_D = (DFF / 64) * (D / 32), I_IN = 16 * (INC / 32), I_SQ = 16 * 32, I_KV = 16 * 64;
    constexpr int NITEMS = 2 * I_GU + 2 * I_D + I_IN + 3 * I_SQ + I_KV;
    for (int it = F.gw; it < NITEMS; it += F.NGW) {
        int r = it;
        if (r < 2 * I_GU) {
            const int which = r / I_GU; r -= which * I_GU; const int nb = r % (NGU / 32), kb = r / (NGU / 32), n0 = 32 * nb, t = n0 / 256, w = n0 % 256, half = w / 128, col = 128 * t + (w % 128);
            const float* W = F.in[(which ? 18 : 3) + half]; const float* g = F.in[which ? 17 : 2];
            transpose_item(W, DFF, col, g, (bf16*)(ws + (which ? WS_WGU2 : WS_WGU1)), D, n0, 64 * kb, scr, F.lane); continue; }
        r -= 2 * I_GU;
        if (r < 2 * I_D) { const int which = r / I_D; r -= which * I_D; const int nb = r % (D / 32), kb = r / (D / 32);
            transpose_item(F.in[which ? 20 : 5], D, 32 * nb, nullptr, (bf16*)(ws + (which ? WS_WD2 : WS_WD1)), DFF, 32 * nb, 64 * kb, scr, F.lane); continue; }
        r -= 2 * I_D;
        if (r < I_IN) { const int nb = r % (INC / 32), kb = r / (INC / 32), n0 = 32 * nb; int col = n0;
            if (n0 >= 2560) { const int t = (n0 - 2560) / 256, w = (n0 - 2560) % 256, half = w / 128; col = (half ? 3072 : 2560) + 128 * t + (w % 128); }
            transpose_item(F.in[7], INC, col, F.in[6], (bf16*)(ws + WS_WIN), D, n0, 64 * kb, scr, F.lane); continue; }
        r -= I_IN;
        if (r < 3 * I_SQ) { const int which = r / I_SQ; r -= which * I_SQ; const int nb = r % 32, kb = r / 32;
            const float* W = F.in[which == 0 ? 11 : (which == 1 ? 14 : 16)]; const float* g = which == 1 ? F.in[12] : nullptr;
            bf16* dst = (bf16*)(ws + (which == 0 ? WS_WOUT : (which == 1 ? WS_WQ : WS_WO)));
            transpose_item(W, D, 32 * nb, g, dst, D, 32 * nb, 64 * kb, scr, F.lane); continue; }
        r -= 3 * I_SQ;
        { const int nb = r % 64, kb = r / 64; transpose_item(F.in[15], 2 * D, 32 * nb, nullptr, (bf16*)(ws + WS_WKV), D, 32 * nb, 64 * kb, scr, F.lane); }
    }
    for (int m = F.gw; m < M; m += F.NGW) norm_row_bf16(F.in[0] + (size_t)m * D, nullptr, (bf16*)(ws + WS_XN) + (size_t)m * D, F.lane);
    for (int m = F.gw; m < MROWS; m += F.NGW) norm_row_bf16(F.in[1] + (size_t)m * D, F.in[13], (bf16*)(ws + WS_MN) + (size_t)m * D, F.lane);
    if (F.gtid < HF) { const float p0 = F.in[8][F.gtid], p1 = F.in[8][HF + F.gtid]; const float mx = fmaxf(p0, p1), e0 = __expf(p0 - mx), e1 = __expf(p1 - mx);
        ((float*)(ws + WS_LB))[F.gtid] = e0 / (e0 + e1); }
}

__device__ __forceinline__ void p_final(const Frame& F) {
    const float* g = F.in[21];
    for (int m = F.gw; m < M; m += F.NGW) {
        f32x4* xr = (f32x4*)(F.out + (size_t)m * D) + F.lane; f32x4 v[4]; float s = 0.f;
#pragma unroll
        for (int j = 0; j < 4; ++j) { v[j] = xr[64 * j]; s += (v[j].x * v[j].x + v[j].y * v[j].y) + (v[j].z * v[j].z + v[j].w * v[j].w); }
        const float r = 1.f / sqrtf(wave_sum(s) * (1.f / D) + EPS);
#pragma unroll
        for (int j = 0; j < 4; ++j) { const f32x4 gg = ((const f32x4*)g)[F.lane + 64 * j]; xr[64 * j] = (f32x4){v[j].x * r * gg.x, v[j].y * r * gg.y, v[j].z * r * gg.z, v[j].w * r * gg.w}; }
    }
}

__device__ __forceinline__ void p_conv(const Frame& F) {
    const bf16* ZB = (const bf16*)(F.ws + WS_ZB); const bf16* P = (const bf16*)(F.ws + WS_P); bf16* Y = (bf16*)(F.ws + WS_Y); const float* cw = F.in[10];
    const long nitem = (long)M * 64;
    for (long i = F.gtid; i < nitem; i += F.NT) {
        const int row = (int)(i >> 6), c8 = (int)(i & 63) * 8, t = row % SEQ;
        float zb[8], p0[8], p1[8], p2[8], o[8];
        unpack8(*(const v4u*)(ZB + (size_t)row * 512 + c8), zb);
        unpack8(*(const v4u*)(P + (size_t)row * 512 + c8), p2);
        if (t >= 1) unpack8(*(const v4u*)(P + (size_t)(row - 1) * 512 + c8), p1); else {
#pragma unroll
            for (int j = 0; j < 8; ++j) p1[j] = 0.f; }
        if (t >= 2) unpack8(*(const v4u*)(P + (size_t)(row - 2) * 512 + c8), p0); else {
#pragma unroll
            for (int j = 0; j < 8; ++j) p0[j] = 0.f; }
#pragma unroll
        for (int j = 0; j < 8; ++j) { const float* w = cw + (c8 + j) * 3; o[j] = zb[j] * (w[0] * p0[j] + w[1] * p1[j] + w[2] * p2[j]); }
        *(v4u*)(Y + (size_t)row * D + 512 + c8) = pack8(o);
    }
}

typedef short bf16x8 __attribute__((ext_vector_type(8)));
typedef short bf16x4 __attribute__((ext_vector_type(4)));
#define MFMA16(a, b, c) __builtin_amdgcn_mfma_f32_16x16x32_bf16((a), (b), (c), 0, 0, 0)
__device__ __forceinline__ v2u pk4(f32x4 v) { v2u w; w.x = pk2(v[0], v[1]); w.y = pk2(v[2], v[3]); return w; }

struct ChunkRegs { f32x4 lf[4]; v4u kw[2]; v4u qw[2]; v4u vw[2]; };
template <bool WITH_Q>
__device__ __forceinline__ void chunk_load(ChunkRegs& R, const unsigned char* ws, int u, int dk, int sq) {
    const int c = u & 63, h = (u >> 6) & 3, b = u >> 8;
    const size_t roff = (size_t)(h * 128 + dk) * M + (size_t)b * SEQ + c * 64 + sq * 16;
    const float* LOGFT = (const float*)(ws + WS_LOGF) + roff; const bf16* KT = (const bf16*)(ws + WS_KK) + roff; const bf16* VT = (const bf16*)(ws + WS_V) + roff; const bf16* QT = (const bf16*)(ws + WS_Q) + roff;
#pragma unroll
    for (int i = 0; i < 4; ++i) R.lf[i] = *(const f32x4*)(LOGFT + 4 * i);
#pragma unroll
    for (int i = 0; i < 2; ++i) { R.kw[i] = *(const v4u*)(KT + 8 * i); R.vw[i] = *(const v4u*)(VT + 8 * i); if (WITH_Q) R.qw[i] = *(const v4u*)(QT + 8 * i); }
}
__device__ __forceinline__ float chunk_cumsum(const ChunkRegs& R, int lane, int sq, float (&bt)[16]) {
    float run = 0.f;
#pragma unroll
    for (int i = 0; i < 16; ++i) { run += R.lf[i >> 2][i & 3]; bt[i] = run; }
    const int base = lane & ~3;
    const float t0 = __shfl(run, base), t1 = __shfl(run, base + 1), t2 = __shfl(run, base + 2), t3 = __shfl(run, base + 3);
    const float pre = (sq > 0 ? t0 : 0.f) + (sq > 1 ? t1 : 0.f) + (sq > 2 ? t2 : 0.f);
#pragma unroll
    for (int i = 0; i < 16; ++i) bt[i] += pre;
    return (t0 + t1) + (t2 + t3);
}
constexpr int NUNIT = BATCH * NH * NCHUNK;
__device__ __forceinline__ void p_scanA(const Frame& F) {
    unsigned char* ws = F.ws; bf16* DS = (bf16*)(ws + WS_DS); float* DEC = (float*)(ws + WS_DEC);
    LAS unsigned char* KhT = F.lds; LAS unsigned char* VTl = F.lds + 18432;
    const int tid = F.tid, lane = F.lane, w = F.wave, dk = tid >> 2, sq = tid & 3, i16 = lane & 15, q4 = lane >> 4;
    ChunkRegs R;
    int u = F.vcu; if (u < NUNIT) chunk_load<false>(R, ws, u, dk, sq);
    for (; u < NUNIT; u += F.G) {
        float bt[16]; const float tot = chunk_cumsum(R, lane, sq, bt);
        float kf[16]; { float t8[8]; unpack8(R.kw[0], t8);
#pragma unroll
            for (int j = 0; j < 8; ++j) kf[j] = t8[j]; unpack8(R.kw[1], t8);
#pragma unroll
            for (int j = 0; j < 8; ++j) kf[8 + j] = t8[j]; }
        float o0[8], o1[8];
#pragma unroll
        for (int j = 0; j < 8; ++j) { o0[j] = kf[j] * __expf(tot - bt[j]); o1[j] = kf[8 + j] * __expf(tot - bt[8 + j]); }
        *(LAS v4u*)(KhT + dk * 144 + sq * 32) = pack8(o0); *(LAS v4u*)(KhT + dk * 144 + sq * 32 + 16) = pack8(o1);
        *(LAS v4u*)(VTl + dk * 144 + sq * 32) = R.vw[0]; *(LAS v4u*)(VTl + dk * 144 + sq * 32 + 16) = R.vw[1];
        if (sq == 0) DEC[(size_t)u * 128 + dk] = __expf(tot);
        __syncthreads();
        if (u + F.G < NUNIT) chunk_load<false>(R, ws, u + F.G, dk, sq);
        const bf16x8 a0 = *(const LAS bf16x8*)(KhT + (16 * w + i16) * 144 + q4 * 16), a1 = *(const LAS bf16x8*)(KhT + (16 * w + i16) * 144 + 64 + q4 * 16);
#pragma unroll
        for (int dvb = 0; dvb < 8; ++dvb) {
            const bf16x8 b0 = *(const LAS bf16x8*)(VTl + (16 * dvb + i16) * 144 + q4 * 16), b1 = *(const LAS bf16x8*)(VTl + (16 * dvb + i16) * 144 + 64 + q4 * 16);
            f32x4 acc = (f32x4){0.f, 0.f, 0.f, 0.f};
            acc = MFMA16(a0, b0, acc); acc = MFMA16(a1, b1, acc);
            *(v2u*)(DS + (size_t)u * 16384 + (16 * dvb + i16) * 128 + 16 * w + 4 * q4) = pk4(acc);
        }
        __syncthreads();
    }
}
__device__ __forceinline__ void p_scanB(const Frame& F) {
    unsigned* DSu = (unsigned*)(F.ws + WS_DS); const float* DEC = (const float*)(F.ws + WS_DEC);
    for (long e = F.gtid; e < (long)BATCH * NH * 8192; e += F.NT) {
        const int bh = (int)(e >> 13), pr = (int)(e & 8191), dk = (2 * pr) & 127;
        unsigned* p = DSu + (size_t)bh * 64 * 8192 + pr; const float* dec = DEC + (size_t)bh * 64 * 128 + dk;
        float S0 = 0.f, S1 = 0.f;
        for (int c0 = 0; c0 < NCHUNK; c0 += 16) {
            unsigned wv[16]; float d0[16], d1[16];
#pragma unroll
            for (int j = 0; j < 16; ++j) { wv[j] = p[(size_t)(c0 + j) * 8192]; d0[j] = dec[(c0 + j) * 128]; d1[j] = dec[(c0 + j) * 128 + 1]; }
#pragma unroll
            for (int j = 0; j < 16; ++j) { p[(size_t)(c0 + j) * 8192] = pk2(S0, S1); S0 = d0[j] * S0 + bflo(wv[j]); S1 = d1[j] * S1 + bfhi(wv[j]); }
        }
    }
}
constexpr int LC_QS = 0, LC_KS = 17408, LC_VT = 34816, LC_P = 53248, LC_ST = 62464, LC_RED = 97280;
__device__ __forceinline__ void p_scanC(const Frame& F) {
    unsigned char* ws = F.ws; const bf16* DS = (const bf16*)(ws + WS_DS); const bf16* SG = (const bf16*)(ws + WS_SG); bf16* Y = (bf16*)(ws + WS_Y); const float* gh = F.in[9];
    LAS unsigned char* L = F.lds;
    const int tid = F.tid, lane = F.lane, w = F.wave, dk = tid >> 2, sq = tid & 3, i16 = lane & 15, q4 = lane >> 4;
    ChunkRegs R; v4u st[4];
    int u = F.vcu;
    if (u < NUNIT) { chunk_load<true>(R, ws, u, dk, sq);
#pragma unroll
        for (int i = 0; i < 4; ++i) { const int p = tid + 512 * i; st[i] = *(const v4u*)(DS + (size_t)u * 16384 + (p >> 4) * 128 + (p & 15) * 8); } }
    for (; u < NUNIT; u += F.G) {
        const int c = u & 63, h = (u >> 6) & 3, b = u >> 8;
        float bt[16]; (void)chunk_cumsum(R, lane, sq, bt);
        { float kf[8], qf[8];
#pragma unroll
          for (int hh = 0; hh < 2; ++hh) { unpack8(R.kw[hh], kf); unpack8(R.qw[hh], qf);
#pragma unroll
            for (int j = 0; j < 8; ++j) { const int t = 16 * sq + 8 * hh + j; const float e = __expf(bt[8 * hh + j]);
                const int off = t * 272 + ((dk >> 3) ^ (2 * sq)) * 16 + (dk & 7) * 2;
                *(LAS bf16*)(L + LC_QS + off) = (bf16)f2bf(qf[j] * e); *(LAS bf16*)(L + LC_KS + off) = (bf16)f2bf(kf[j] / e); } } }
        *(LAS v4u*)(L + LC_VT + dk * 144 + sq * 32) = R.vw[0]; *(LAS v4u*)(L + LC_VT + dk * 144 + sq * 32 + 16) = R.vw[1];
#pragma unroll
        for (int i = 0; i < 4; ++i) { const int p = tid + 512 * i; *(LAS v4u*)(L + LC_ST + (p >> 4) * 272 + (p & 15) * 16) = st[i]; }
        __syncthreads();
        if (u + F.G < NUNIT) { chunk_load<true>(R, ws, u + F.G, dk, sq);
#pragma unroll
            for (int i = 0; i < 4; ++i) { const int p = tid + 512 * i; st[i] = *(const v4u*)(DS + (size_t)(u + F.G) * 16384 + (p >> 4) * 128 + (p & 15) * 8); } }
        const int row0 = b * SEQ + c * 64, col = h * 128 + 16 * w + 4 * q4;
        v2u sgw[4];
#pragma unroll
        for (int tb = 0; tb < 4; ++tb) sgw[tb] = *(const v2u*)(SG + (size_t)(row0 + 16 * tb + i16) * 512 + col);
        { const int tb = w & 3, sb0 = 2 * (w >> 2);
          f32x4 a0 = (f32x4){0.f, 0.f, 0.f, 0.f}, a1 = a0;
#pragma unroll
          for (int ks = 0; ks < 4; ++ks) {
              const bf16x8 qb = *(const LAS bf16x8*)(L + LC_QS + (16 * tb + i16) * 272 + (((4 * ks + q4) ^ (2 * tb)) * 16));
              const bf16x8 k0 = *(const LAS bf16x8*)(L + LC_KS + (16 * sb0 + i16) * 272 + (((4 * ks + q4) ^ (2 * sb0)) * 16));
              const bf16x8 k1 = *(const LAS bf16x8*)(L + LC_KS + (16 * (sb0 + 1) + i16) * 272 + (((4 * ks + q4) ^ (2 * (sb0 + 1))) * 16));
              a0 = MFMA16(k0, qb, a0); a1 = MFMA16(k1, qb, a1); }
          const int t = 16 * tb + i16;
#pragma unroll
          for (int r = 0; r < 4; ++r) { if (16 * sb0 + 4 * q4 + r > t) a0[r] = 0.f; if (16 * (sb0 + 1) + 4 * q4 + r > t) a1[r] = 0.f; }
          *(LAS v2u*)(L + LC_P + t * 144 + (16 * sb0 + 4 * q4) * 2) = pk4(a0); *(LAS v2u*)(L + LC_P + t * 144 + (16 * (sb0 + 1) + 4 * q4) * 2) = pk4(a1); }
        __syncthreads();
        f32x4 o[4];
        { bf16x8 av[2], as[4];
#pragma unroll
          for (int ks = 0; ks < 2; ++ks) av[ks] = *(const LAS bf16x8*)(L + LC_VT + (16 * w + i16) * 144 + ks * 64 + q4 * 16);
#pragma unroll
          for (int ks = 0; ks < 4; ++ks) as[ks] = *(const LAS bf16x8*)(L + LC_ST + (16 * w + i16) * 272 + (4 * ks + q4) * 16);
#pragma unroll
          for (int tb = 0; tb < 4; ++tb) {
              f32x4 acc = (f32x4){0.f, 0.f, 0.f, 0.f};
#pragma unroll
              for (int ks = 0; ks < 2; ++ks) if (ks == 0 || tb >= 2) acc = MFMA16(av[ks], *(const LAS bf16x8*)(L + LC_P + (16 * tb + i16) * 144 + ks * 64 + q4 * 16), acc);
#pragma unroll
              for (int ks = 0; ks < 4; ++ks) acc = MFMA16(as[ks], *(const LAS bf16x8*)(L + LC_QS + (16 * tb + i16) * 272 + (((4 * ks + q4) ^ (2 * tb)) * 16)), acc);
              o[tb] = acc;
              float ss = (acc[0] * acc[0] + acc[1] * acc[1]) + (acc[2] * acc[2] + acc[3] * acc[3]);
              ss += __shfl_xor(ss, 16); ss += __shfl_xor(ss, 32);
              if (q4 == 0) *(LAS float*)(L + LC_RED + (w * 64 + 16 * tb + i16) * 4) = ss;
          } }
        __syncthreads();
        const f32x4 gv = *(const f32x4*)(gh + col);
#pragma unroll
        for (int tb = 0; tb < 4; ++tb) {
            float tot = 0.f;
#pragma unroll
            for (int ww = 0; ww < 8; ++ww) tot += *(const LAS float*)(L + LC_RED + (ww * 64 + 16 * tb + i16) * 4);
            const float rr = 1.f / sqrtf(tot * (1.f / DV) + EPS);
            v2u yo; yo.x = pk2(o[tb][0] * rr * gv[0] * bflo(sgw[tb].x), o[tb][1] * rr * gv[1] * bfhi(sgw[tb].x)); yo.y = pk2(o[tb][2] * rr * gv[2] * bflo(sgw[tb].y), o[tb][3] * rr * gv[3] * bfhi(sgw[tb].y));
            *(v2u*)(Y + (size_t)(row0 + 16 * tb + i16) * D + col) = yo;
        }
        __syncthreads();
    }
}


constexpr int ATT_BUF = 36864;
__device__ __forceinline__ void att_stage_load(v4u (&pre)[4], const unsigned char* ws, int b, int h, int st, int tid) {
    if (st < 4) {
        const bf16* KM = (const bf16*)(ws + WS_KM) + (size_t)(b * MEML + 64 * st) * D + h * MHD;
#pragma unroll
        for (int i = 0; i < 4; ++i) { const int p = tid + 512 * i; pre[i] = *(const v4u*)(KM + (size_t)(p >> 5) * D + (p & 31) * 8); }
    } else {
        const int hp = (st - 4) >> 2, vc = (st - 4) & 3;
        const bf16* VMT = (const bf16*)(ws + WS_VMT) + (size_t)(h * MHD + 128 * hp) * MROWS + b * MEML + 64 * vc;
#pragma unroll
        for (int i = 0; i < 2; ++i) { const int p = tid + 512 * i; pre[i] = *(const v4u*)(VMT + (size_t)(p >> 3) * MROWS + (p & 7) * 8); }
    }
}
__device__ __forceinline__ void att_stage_write(const v4u (&pre)[4], LAS unsigned char* buf, int st, int tid) {
    if (st < 4) {
#pragma unroll
        for (int i = 0; i < 4; ++i) { const int p = tid + 512 * i; *(LAS v4u*)(buf + (p >> 5) * 528 + (p & 31) * 16) = pre[i]; }
    } else {
#pragma unroll
        for (int i = 0; i < 2; ++i) { const int p = tid + 512 * i; *(LAS v4u*)(buf + (p >> 3) * 144 + (p & 7) * 16) = pre[i]; }
    }
}
__device__ __forceinline__ void p_attn(const Frame& F) {
    unsigned char* ws = F.ws; const bf16* QM = (const bf16*)(ws + WS_QM); bf16* ATT = (bf16*)(ws + WS_ATT);
    const int tid = F.tid, lane = F.lane, w = F.wave, i16 = lane & 15, q4 = lane >> 4;
    for (int u = F.vcu; u < BATCH * MH * (SEQ / 256); u += F.G) {
        const int tblk = u & 15, h = (u >> 4) & 3, b = u >> 6;
        const int tok0 = b * SEQ + tblk * 256 + 32 * w;
        v4u pre[4];
        att_stage_load(pre, ws, b, h, 0, tid);
        const bf16* qp = QM + (size_t)(tok0 + i16) * D + h * MHD + 8 * q4;
        att_stage_write(pre, F.lds, 0, tid);
        __syncthreads();
        f32x4 S[16][2];
#pragma unroll
        for (int i = 0; i < 16; ++i) { S[i][0] = (f32x4){0.f, 0.f, 0.f, 0.f}; S[i][1] = S[i][0]; }
#pragma unroll
        for (int st = 0; st < 4; ++st) {
            att_stage_load(pre, ws, b, h, st + 1, tid);
            LAS unsigned char* buf = F.lds + (st & 1) * ATT_BUF;
#pragma unroll
            for (int ks = 0; ks < 8; ++ks) {
                const bf16x8 q0 = *(const bf16x8*)(qp + 32 * ks), q1 = *(const bf16x8*)(qp + 16 * D + 32 * ks);
#pragma unroll
                for (int mt = 0; mt < 4; ++mt) {
                    const bf16x8 kf = *(const LAS bf16x8*)(buf + (16 * mt + i16) * 528 + (32 * ks + 8 * q4) * 2);
                    S[4 * st + mt][0] = MFMA16(kf, q0, S[4 * st + mt][0]); S[4 * st + mt][1] = MFMA16(kf, q1, S[4 * st + mt][1]);
                }
            }
            att_stage_write(pre, F.lds + ((st + 1) & 1) * ATT_BUF, st + 1, tid);
            __syncthreads();
        }
        bf16x8 pf[8][2]; float inv[2];
#pragma unroll
        for (int tt = 0; tt < 2; ++tt) {
            float mx = -3.0e38f;
#pragma unroll
            for (int i = 0; i < 16; ++i) mx = fmaxf(mx, fmaxf(fmaxf(S[i][tt][0], S[i][tt][1]), fmaxf(S[i][tt][2], S[i][tt][3])));
            mx = fmaxf(mx, __shfl_xor(mx, 16)); mx = fmaxf(mx, __shfl_xor(mx, 32));
            float l = 0.f;
#pragma unroll
            for (int k2 = 0; k2 < 8; ++k2) {
                float e[8];
#pragma unroll
                for (int r = 0; r < 4; ++r) { e[r] = __expf(S[2 * k2][tt][r] - mx); e[4 + r] = __expf(S[2 * k2 + 1][tt][r] - mx); }
#pragma unroll
                for (int r = 0; r < 8; ++r) l += e[r];
                pf[k2][tt] = __builtin_bit_cast(bf16x8, pack8(e));
            }
            l += __shfl_xor(l, 16); l += __shfl_xor(l, 32);
            inv[tt] = 1.f / l;
        }
#pragma unroll
        for (int hp = 0; hp < 2; ++hp) {
            f32x4 O[8][2];
#pragma unroll
            for (int i = 0; i < 8; ++i) { O[i][0] = (f32x4){0.f, 0.f, 0.f, 0.f}; O[i][1] = O[i][0]; }
#pragma unroll
            for (int vc = 0; vc < 4; ++vc) {
                const int st = 4 + 4 * hp + vc;
                if (st < 11) att_stage_load(pre, ws, b, h, st + 1, tid);
                LAS unsigned char* buf = F.lds + (st & 1) * ATT_BUF;
#pragma unroll
                for (int k2 = 0; k2 < 2; ++k2)
#pragma unroll
                    for (int hdt = 0; hdt < 8; ++hdt) {
                        const bf16x4 lo = *(const LAS bf16x4*)(buf + (16 * hdt + i16) * 144 + (32 * k2 + 4 * q4) * 2), hi = *(const LAS bf16x4*)(buf + (16 * hdt + i16) * 144 + (32 * k2 + 16 + 4 * q4) * 2);
                        const bf16x8 vf = __builtin_shufflevector(lo, hi, 0, 1, 2, 3, 4, 5, 6, 7);
                        O[hdt][0] = MFMA16(vf, pf[2 * vc + k2][0], O[hdt][0]); O[hdt][1] = MFMA16(vf, pf[2 * vc + k2][1], O[hdt][1]);
                    }
                if (st < 11) att_stage_write(pre, F.lds + ((st + 1) & 1) * ATT_BUF, st + 1, tid);
                __syncthreads();
            }
#pragma unroll
            for (int tt = 0; tt < 2; ++tt)
#pragma unroll
                for (int hdt = 0; hdt < 8; ++hdt) {
                    const f32x4 v = O[hdt][tt] * inv[tt];
                    *(v2u*)(ATT + (size_t)(tok0 + 16 * tt + i16) * D + h * MHD + 128 * hp + 16 * hdt + 4 * q4) = pk4(v);
                }
        }
    }
}

#define GEMM1(multi, rmode, Ap, Bp, Mr, Nn, Kk, EmT, emv, rsp) GEMM1C(multi, rmode, (int)blockIdx.x, Ap, Bp, Mr, Nn, Kk, EmT, emv, rsp)
#define GEMM1C(multi, rmode, cc, Ap, Bp, Mr, Nn, Kk, EmT, emv, rsp) do { \
        pg8::Sched1 S_{(Ap), (Bp), (Mr) / 256, (Nn) / 256, F.G, (cc)}; pg8::EpiEmit<EmT, rmode> E_{emv, (rsp)}; \
        pg8::gemm_phase<pg8::EpiEmit<EmT, rmode>, pg8::Sched1, multi, true>(F.lds, (Kk), S_, E_); } while (0)

struct Args { const float* in[22]; float* out; unsigned char* ws; int ph_lo, ph_hi; };
__global__ void __launch_bounds__(NTHR, 2) fwd(Args args) {
    extern __shared__ __attribute__((aligned(16))) unsigned char lds[];
    Frame F;
    F.lds = (LAS unsigned char*)lds;
    F.tid = threadIdx.x; F.lane = F.tid & 63; F.wave = __builtin_amdgcn_readfirstlane(F.tid >> 6);
    F.G = gridDim.x; { const int bx = blockIdx.x; F.vcu = (F.G % 8 == 0) ? (bx % 8) * (F.G / 8) + bx / 8 : bx; }
    F.gtid = (long)F.vcu * NTHR + F.tid; F.NT = (long)F.G * NTHR; F.gw = F.vcu * NWAVES + F.wave; F.NGW = F.G * NWAVES;
    F.in = args.in;
    F.out = args.out; F.ws = args.ws;
    unsigned char* ws = args.ws;
    const int lo = args.ph_lo, hi = args.ph_hi;
    for (int u = F.tid; u < (LDS_BYTES - LDSCTL_OFF) / 4; u += NTHR) ((LAS unsigned*)(F.lds + LDSCTL_OFF))[u] = 0u;
    __syncthreads();
    XcdBarrier bar; bar.bar = (unsigned*)(ws + WS_CTL) + CW_BAR; bar.x = 0; bar.st = nullptr;
    if (hi - lo > 1) bar = xcd_barrier_post((unsigned*)(ws + WS_CTL) + CW_BAR, (volatile LAS unsigned*)(F.lds + MISC_OFF) + 8);
#define IN(k) (lo <= (k) && (k) < hi)
#define SEAM(k) do { if (IN(k) && IN((k) + 1)) xcd_barrier(bar); } while (0)
    float* RSP = (float*)(ws + WS_RSP);
    if (IN(0)) p_prologue(F);
    SEAM(0);
    if (IN(1)) {
        GEMM1(true, 0, (const bf16*)(ws + WS_XN), (const bf16*)(ws + WS_WGU1), M, NGU, D, EmGU, (EmGU{(bf16*)(ws + WS_HID)}), nullptr);
        GEMM1C(false, 0, (int)blockIdx.x - 128, (const bf16*)(ws + WS_MN), (const bf16*)(ws + WS_WKV), MROWS, D, D, EmPlain, (EmPlain{(bf16*)(ws + WS_KM), 1.f}), nullptr);
        GEMM1C(false, 0, (int)blockIdx.x - 144, (const bf16*)(ws + WS_WKV) + (size_t)D * D, (const bf16*)(ws + WS_MN), D, MROWS, D, EmPlain, (EmPlain{(bf16*)(ws + WS_VMT), 1.f}), nullptr);
    }
    SEAM(1);
    if (IN(2)) GEMM1(false, 3, (const bf16*)(ws + WS_HID), (const bf16*)(ws + WS_WD1), M, D, DFF, EmRes, (EmRes{F.in[0], F.out, (bf16*)(ws + WS_XB), 0.5f}), RSP);
    SEAM(2);
    if (IN(3)) {
        GEMM1(true, 1, (const bf16*)(ws + WS_XB), (const bf16*)(ws + WS_WIN) + (size_t)1536 * D, M, 2048, D, EmInA, (EmInA{(bf16*)(ws + WS_SG), (bf16*)(ws + WS_ZB), (bf16*)(ws + WS_P)}), RSP);
        GEMM1(true, 2, (const bf16*)(ws + WS_WIN), (const bf16*)(ws + WS_XB), 1536, M, D, EmInB,
              (EmInB{(bf16*)(ws + WS_Q), (bf16*)(ws + WS_KK), (bf16*)(ws + WS_V), (float*)(ws + WS_LOGF), (const float*)(ws + WS_LB)}), RSP);
    }
    SEAM(3);
    if (IN(4)) { p_conv(F); p_scanA(F); }
    SEAM(4);
    if (IN(5)) p_scanB(F);
    SEAM(5);
    if (IN(6)) p_scanC(F);
    SEAM(6);
    if (IN(7)) GEMM1(false, 3, (const bf16*)(ws + WS_Y), (const bf16*)(ws + WS_WOUT), M, D, D, EmRes, (EmRes{F.out, F.out, (bf16*)(ws + WS_XB2), 1.f}), RSP);
    SEAM(7);
    if (IN(8)) GEMM1(false, 1, (const bf16*)(ws + WS_XB2), (const bf16*)(ws + WS_WQ), M, D, D, EmPlain, (EmPlain{(bf16*)(ws + WS_QM), 0.0625f}), RSP);
    SEAM(8);
    if (IN(9)) p_attn(F);
    SEAM(9);
    if (IN(10)) GEMM1(false, 3, (const bf16*)(ws + WS_ATT), (const bf16*)(ws + WS_WO), M, D, D, EmRes, (EmRes{F.out, F.out, (bf16*)(ws + WS_XB2), 1.f}), RSP);
    SEAM(10);
    if (IN(11)) GEMM1(true, 1, (const bf16*)(ws + WS_XB2), (const bf16*)(ws + WS_WGU2), M, NGU, D, EmGU, (EmGU{(bf16*)(ws + WS_HID)}), RSP);
    SEAM(11);
    if (IN(12)) GEMM1(false, 3, (const bf16*)(ws + WS_HID), (const bf16*)(ws + WS_WD2), M, D, DFF, EmRes, (EmRes{F.out, F.out, nullptr, 0.5f}), nullptr);
    SEAM(12);
    if (IN(13)) p_final(F);
#undef IN
#undef SEAM
}

extern "C" void kernel_launch(void* const* d_in, const int* in_sizes, int n_in, void* d_out, int out_size, void* d_ws, size_t ws_size, hipStream_t stream) {
    static int grid = 0;
    if (grid == 0) {
        if (n_in != 22 || in_sizes[0] != M * D || out_size != M * D || ws_size < WS_END) { fprintf(stderr, "kernel_launch: unexpected shapes (n_in %d, in0 %d, out %d, ws %zu)\n", n_in, n_in > 0 ? in_sizes[0] : -1, out_size, ws_size); grid = -1; return; }
        int dev = 0, cus = 0;
        if (hipGetDevice(&dev) != hipSuccess || hipDeviceGetAttribute(&cus, hipDeviceAttributeMultiprocessorCount, dev) != hipSuccess) { grid = -1; return; }
        if (hipFuncSetAttribute((const void*)fwd, hipFuncAttributeMaxDynamicSharedMemorySize, LDS_BYTES) != hipSuccess) { fprintf(stderr, "kernel_launch: hipFuncSetAttribute failed\n"); grid = -1; return; }
        grid = cus;
    }
    if (grid < 0) return;
    Args a{};
    for (int i = 0; i < 22; ++i) a.in[i] = (const float*)d_in[i];
    a.out = (float*)d_out; a.ws = (unsigned char*)d_ws;
    if (hipMemsetAsync((char*)d_ws + WS_CTL, 0, CTL_ZERO_BYTES, stream) != hipSuccess) { fprintf(stderr, "kernel_launch: memset failed\n"); return; }
    a.ph_lo = 0; a.ph_hi = NPHASE;
    void* kargs[] = {&a};
    hipError_t e = hipLaunchCooperativeKernel((const void*)fwd, dim3(grid), dim3(NTHR), kargs, LDS_BYTES, stream);
    if (e != hipSuccess) fprintf(stderr, "kernel_launch: cooperative launch failed: %s (grid %d)\n", hipGetErrorString(e), grid);
}
```

```cpp
#include <hip/hip_runtime.h>
#include <cstdio>
#include <cstdint>

#define GAS __attribute__((address_space(1)))
#define LAS __attribute__((address_space(3)))
typedef unsigned short bf16;
typedef unsigned v4u __attribute__((ext_vector_type(4)));
typedef unsigned v2u __attribute__((ext_vector_type(2)));
typedef float f32x4 __attribute__((ext_vector_type(4)));

constexpr int BATCH = 4, SEQ = 4096, D = 1024, M = BATCH * SEQ, DFF = 2816, NGU = 2 * DFF, INC = 3584;
constexpr int HF = 512, NH = 4, DK = 128, DV = 128, CHUNK = 64, NCHUNK = SEQ / CHUNK;
constexpr int MEML = 256, MH = 4, MHD = 256, MROWS = BATCH * MEML;
constexpr float EPS = 1e-6f;
constexpr int NWAVES = 8, NTHR = NWAVES * 64;
constexpr int NPHASE = 14;

constexpr size_t MiB = 1u << 20;
constexpr size_t WS_CTL = 0, CTL_ZERO_BYTES = 1 * MiB;
constexpr size_t WS_LB = 1 * MiB, WS_RS = 1 * MiB + 65536;
constexpr size_t WS_WGU1 = 2 * MiB, WS_WD1 = 13 * MiB, WS_WIN = WS_WD1 + 5 * MiB + 512 * 1024, WS_WOUT = WS_WIN + 7 * MiB, WS_WQ = WS_WOUT + 2 * MiB,
                 WS_WKV = WS_WQ + 2 * MiB, WS_WO = WS_WKV + 4 * MiB, WS_WGU2 = WS_WO + 2 * MiB, WS_WD2 = WS_WGU2 + 11 * MiB, WS_MN = 52 * MiB, WS_KM = 54 * MiB, WS_VMT = 56 * MiB,
                 WS_DEC = 58 * MiB, WS_RSP = 59 * MiB;
static_assert(WS_WD2 + 5 * MiB + 512 * 1024 == WS_MN, "weight map");
constexpr size_t WS_XN = 64 * MiB, WS_HID = 96 * MiB, WS_XB = 216 * MiB;
constexpr size_t WS_Q = 64 * MiB, WS_KK = 80 * MiB, WS_LOGF = 96 * MiB, WS_V = 128 * MiB, WS_SG = 144 * MiB, WS_ZB = 160 * MiB, WS_P = 176 * MiB, WS_DS = 192 * MiB, WS_Y = 224 * MiB;
constexpr size_t WS_XB2 = 64 * MiB, WS_QM = 96 * MiB, WS_ATT = 128 * MiB, WS_END = 256 * MiB;

constexpr int RING_BYTES = 131072, LDSCTL_OFF = RING_BYTES, MISC_OFF = LDSCTL_OFF + 320, LDS_BYTES = 147456;

__device__ __forceinline__ unsigned f2bf(float f) { unsigned u = __builtin_bit_cast(unsigned, f); return (u + 0x7fffu + ((u >> 16) & 1u)) >> 16; }
__device__ __forceinline__ unsigned pk2(float lo, float hi) { return f2bf(lo) | (f2bf(hi) << 16); }
__device__ __forceinline__ float bflo(unsigned w) { return __builtin_bit_cast(float, w << 16); }
__device__ __forceinline__ float bfhi(unsigned w) { return __builtin_bit_cast(float, w & 0xffff0000u); }
__device__ __forceinline__ float bf2f(bf16 b) { return __builtin_bit_cast(float, (unsigned)b << 16); }
__device__ __forceinline__ float wave_sum(float v) {
#pragma unroll
    for (int o = 1; o < 64; o <<= 1) v += __shfl_xor(v, o);
    return v;
}
__device__ __forceinline__ float wave_max(float v) {
#pragma unroll
    for (int o = 1; o < 64; o <<= 1) v = fmaxf(v, __shfl_xor(v, o));
    return v;
}
__device__ __forceinline__ float silu_f(float x) { return x / (1.f + __expf(-x)); }
__device__ __forceinline__ float sigm_f(float x) { return 1.f / (1.f + __expf(-x)); }
__device__ __forceinline__ void unpack8(v4u w, float (&f)[8]) {
    f[0] = bflo(w.x); f[1] = bfhi(w.x); f[2] = bflo(w.y); f[3] = bfhi(w.y); f[4] = bflo(w.z); f[5] = bfhi(w.z); f[6] = bflo(w.w); f[7] = bfhi(w.w);
}
__device__ __forceinline__ v4u pack8(const float (&f)[8]) { v4u w; w.x = pk2(f[0], f[1]); w.y = pk2(f[2], f[3]); w.z = pk2(f[4], f[5]); w.w = pk2(f[6], f[7]); return w; }


typedef GAS unsigned gu32;
constexpr int CW_TMO = 0, CW_CODE = 1, CW_BAR = 4096;
#define XB_TMO      128
#define XB_XCNT(j)  (256  + 64 * (j))
#define XB_XSUB(j)  (1280 + 64 * (j))
#define XB_XGEN(j)  (2304 + 64 * (j))
#define XB_TOP      3328
#define XB_TOPGEN   3392
#define XCD_BAR_WORDS 3456
#define XB_SPIN_CAP (1u << 18)
__device__ __forceinline__ unsigned xb_ld(unsigned* p)              { return __hip_atomic_load(p, __ATOMIC_RELAXED, __HIP_MEMORY_SCOPE_AGENT); }
__device__ __forceinline__ unsigned xb_add(unsigned* p, unsigned v) { return __hip_atomic_fetch_add(p, v, __ATOMIC_RELAXED, __HIP_MEMORY_SCOPE_AGENT); }
__device__ __forceinline__ unsigned xb_xcc_id() { return (unsigned)__builtin_amdgcn_s_getreg((3 << 11) | 20) & 0xFu; }
#define XB_SPIN(cond, bar) do { unsigned _sp = 0; while (cond) { __builtin_amdgcn_s_sleep(1); \
    if ((++_sp & 255u) == 0u) { if (xb_ld(&(bar)[XB_TMO])) break; if (_sp > XB_SPIN_CAP) { atomicAdd(&(bar)[XB_TMO], 1u); break; } } } } while (0)
struct XcdBarrier { unsigned* bar; unsigned x; volatile LAS unsigned* st; };
__device__ __forceinline__ XcdBarrier xcd_barrier_post(unsigned* bar, volatile LAS unsigned* st) {
    XcdBarrier b; b.bar = bar; b.x = xb_xcc_id(); b.st = st;
    if (threadIdx.x == 0) (void)xb_add(&bar[XB_XCNT(b.x)], 1u);
    return b;
}
__device__ __forceinline__ void xcd_barrier_complete(unsigned* bar, unsigned x, unsigned& nloc, unsigned& nx) {
    const unsigned G = gridDim.x * gridDim.y * gridDim.z;
    unsigned sum, cnt, mine, sp = 0u;
    for (;;) {
        sum = 0u; cnt = 0u; mine = 0u;
#pragma unroll
        for (unsigned j = 0; j < 16; ++j) { const unsigned c = xb_ld(&bar[XB_XCNT(j)]); sum += c; cnt += (c > 0u) ? 1u : 0u; mine = (j == x) ? c : mine; }
        if (sum == G) break;
        __builtin_amdgcn_s_sleep(1);
        if ((++sp & 255u) == 0u) { if (xb_ld(&bar[XB_TMO])) break; if (sp > XB_SPIN_CAP) { atomicAdd(&bar[XB_TMO], 1u); break; } }
    }
    nloc = mine > 0u ? mine : 1u; nx = cnt > 0u ? cnt : 1u;
}
__device__ __forceinline__ void xcd_barrier(const XcdBarrier& b) {
    asm volatile("s_waitcnt vmcnt(0)" ::: "memory");
    __syncthreads();
    if (threadIdx.x == 0) {
        unsigned* bar = b.bar;
        __builtin_amdgcn_s_waitcnt(0);
        unsigned nloc = b.st[0], nx = b.st[1];
        if (nloc == 0u) { xcd_barrier_complete(bar, b.x, nloc, nx); b.st[0] = nloc; b.st[1] = nx; }
        const unsigned old = xb_add(&bar[XB_XSUB(b.x)], 1u);
        const unsigned gen = old / nloc;
        if (old + 1u == (gen + 1u) * nloc) {
            __builtin_amdgcn_fence(__ATOMIC_RELEASE, "agent");
            asm volatile("s_waitcnt vmcnt(0)" ::: "memory");
            const unsigned og = xb_add(&bar[XB_TOP], 1u);
            const unsigned tg = og / nx;
            if (og + 1u == (tg + 1u) * nx) xb_add(&bar[XB_TOPGEN], 1u);
            else XB_SPIN(xb_ld(&bar[XB_TOPGEN]) == tg, bar);
            __builtin_amdgcn_fence(__ATOMIC_ACQUIRE, "agent");
            xb_add(&bar[XB_XGEN(b.x)], 1u);
            asm volatile("s_waitcnt vmcnt(0)" ::: "memory");
        } else {
            XB_SPIN(xb_ld(&bar[XB_XGEN(b.x)]) == gen, bar);
            __builtin_amdgcn_fence(__ATOMIC_ACQUIRE, "agent");
            asm volatile("s_waitcnt vmcnt(0)" ::: "memory");
        }
    }
    __syncthreads();
}

struct Frame {
    LAS unsigned char* lds;
    int tid, lane, wave, vcu, G;
    long gtid, NT;
    int gw, NGW;
    const float* const* in; float* out; unsigned char* ws;
};

struct EmGU {
    bf16* HID;
    __device__ __forceinline__ void operator()(int row, int pn, int c8, const float (&a)[8], const float (&b)[8], float r) const {
        float h[8];
#pragma unroll
        for (int j = 0; j < 8; ++j) h[j] = silu_f(r * a[j]) * (r * b[j]);
        *(v4u*)(HID + (size_t)row * DFF + 128 * pn + c8) = pack8(h);
    }
};
struct EmRes {
    const float* XIN; float* XF; bf16* XB; float scale;
    __device__ __forceinline__ float operator()(int row, int pn, int c8, const float (&a)[8], const float (&b)[8]) const {
        float ss = 0.f;
#pragma unroll
        for (int hh = 0; hh < 2; ++hh) {
            const size_t off = (size_t)row * D + 256 * pn + 128 * hh + c8;
            const f32x4 x0 = *(const f32x4*)(XIN + off), x1 = *(const f32x4*)(XIN + off + 4);
            float o[8];
#pragma unroll
            for (int j = 0; j < 4; ++j) { o[j] = x0[j] + scale * (hh ? b[j] : a[j]); o[4 + j] = x1[j] + scale * (hh ? b[4 + j] : a[4 + j]); }
#pragma unroll
            for (int j = 0; j < 8; ++j) ss += o[j] * o[j];
            *(f32x4*)(XF + off) = (f32x4){o[0], o[1], o[2], o[3]}; *(f32x4*)(XF + off + 4) = (f32x4){o[4], o[5], o[6], o[7]};
            if (XB) *(v4u*)(XB + off) = pack8(o);
        }
        return ss;
    }
};
struct EmInA {
    bf16 *SG, *ZB, *P;
    __device__ __forceinline__ void operator()(int row, int pn, int c8, const float (&a)[8], const float (&b)[8], float r) const {
        if (pn >= 4) {
            float o[8];
#pragma unroll
            for (int j = 0; j < 8; ++j) o[j] = (r * a[j]) * (r * b[j]);
            *(v4u*)(P + (size_t)row * 512 + 128 * (pn - 4) + c8) = pack8(o);
            return;
        }
#pragma unroll
        for (int hh = 0; hh < 2; ++hh) {
            const size_t off = (size_t)row * 512 + 256 * (pn & 1) + 128 * hh + c8;
            float z[8];
#pragma unroll
            for (int j = 0; j < 8; ++j) z[j] = r * (hh ? b[j] : a[j]);
            if (pn < 2) {
#pragma unroll
                for (int j = 0; j < 8; ++j) z[j] = silu_f(z[j]);
                *(v4u*)(SG + off) = pack8(z);
            } else *(v4u*)(ZB + off) = pack8(z);
        }
    }
};
struct EmInB {
    bf16 *QT, *KT, *VT; float* LOGFT; const float* LB;
    __device__ __forceinline__ void operator()(int row, int pn, int c8, const float (&a)[8], const float (&b)[8], const float (&r0)[8], const float (&r1)[8]) const {
        const int kind = row >> 9, ch = row & 511;
        const float lb = LB[ch];
#pragma unroll
        for (int hh = 0; hh < 2; ++hh) {
            const int tok = 256 * pn + 128 * hh + c8; const size_t off = (size_t)ch * M + tok;
            float z[8], o[8];
#pragma unroll
            for (int j = 0; j < 8; ++j) z[j] = hh ? r1[j] * b[j] : r0[j] * a[j];
            if (kind == 0) {
#pragma unroll
                for (int j = 0; j < 8; ++j) o[j] = silu_f(z[j]) * 0.08838834764831845f;
                *(v4u*)(QT + off) = pack8(o);
            } else if (kind == 1) {
                float lf[8];
#pragma unroll
                for (int j = 0; j < 8; ++j) { const float f = lb + (1.f - lb) * sigm_f(z[j]); o[j] = 1.f - f; lf[j] = __logf(f); }
                *(v4u*)(KT + off) = pack8(o);
                *(f32x4*)(LOGFT + off) = (f32x4){lf[0], lf[1], lf[2], lf[3]}; *(f32x4*)(LOGFT + off + 4) = (f32x4){lf[4], lf[5], lf[6], lf[7]};
            } else *(v4u*)(VT + off) = pack8(z);
        }
    }
};
struct EmPlain {
    bf16* O; float scale;
    __device__ __forceinline__ void operator()(int row, int pn, int c8, const float (&a)[8], const float (&b)[8], float r) const {
        const float rs = r * scale; float o[8];
#pragma unroll
        for (int j = 0; j < 8; ++j) o[j] = rs * a[j];
        *(v4u*)(O + (size_t)row * 1024 + 256 * pn + c8) = pack8(o);
#pragma unroll
        for (int j = 0; j < 8; ++j) o[j] = rs * b[j];
        *(v4u*)(O + (size_t)row * 1024 + 256 * pn + 128 + c8) = pack8(o);
    }
};

namespace pg8 {
#define PG8_LAS __attribute__((address_space(3)))
typedef unsigned short bf16_t;
typedef short bf16x8 __attribute__((ext_vector_type(8)));
typedef unsigned u32x4 __attribute__((ext_vector_type(4)));
constexpr int BM = 256, BK = 64, HALF = 128, HTB = HALF * BK * 2, STAGE_BYTES = 8 * HTB, NXCD = 8, WGM = 8;
__host__ __device__ __forceinline__ int lds_byte(int r, int c) { const int st = (r >> 4) * 2 + (c >> 5), rr = r & 15, cc = c & 31, ob = rr * 64 + cc * 2; return st * 1024 + (ob ^ (((ob >> 9) & 1) << 5)); }
__host__ __device__ __forceinline__ void stage_rc(int b, int& R, int& C) { const int st = b / 1024, sb = b % 1024, swz = sb ^ (((sb >> 9) & 1) << 5); R = (st >> 1) * 16 + swz / 64; C = (st & 1) * 32 + (swz % 64) / 2; }
__host__ __device__ __forceinline__ int perm32(int rho) { const int n = rho >> 4, i = rho & 15; return 8 * (i >> 2) + 4 * n + (i & 3); }
struct Unit { int pm, pn, gid; };
__device__ __forceinline__ void order_map(int L, int nM, int nN, Unit& u) {
    const int nwg = nM * nN; int wgid = L; { const int q = nwg / NXCD, r = nwg % NXCD, xcd = wgid % NXCD, off = wgid / NXCD; wgid = (xcd < r ? xcd * (q + 1) : r * (q + 1) + (xcd - r) * q) + off; }
    const int nig = WGM * nN, gid = wgid / nig, fm = gid * WGM, gsz = (nM - fm) < WGM ? (nM - fm) : WGM;
    u.pm = fm + ((wgid % nig) % gsz); u.pn = (wgid % nig) / gsz;
}
struct Sched1 {
    const bf16_t* A; const bf16_t* Bt; int nM, nN, G, c;
    __device__ __forceinline__ bool next(int i, Unit& u) const { const long L = (long)i * G + c; if (c < 0 || L >= (long)nM * nN) return false; order_map((int)L, nM, nN, u); u.gid = 0; return true; }
    __device__ __forceinline__ const char* tileA(const Unit& u, size_t tstep) const { return (const char*)A + (size_t)u.pm * tstep; }
    __device__ __forceinline__ const char* tileB(const Unit& u, size_t tstep) const { return (const char*)Bt + (size_t)u.pn * tstep; }
    __device__ __forceinline__ void a_ready(const Unit&) const {}
    __device__ __forceinline__ void done(const Unit&) const {}
};
template <class Emit, int RMODE> struct EpiEmit {
    static constexpr bool PERM = true, AFTER_DRAIN = false; Emit E; float* RSP;
    __device__ __forceinline__ void operator()(const f32x4 (&acc)[2][2][4][2], const Unit& u, int wr, int wc, int fr, int fq) const {
        float r0[8], r1[8];
        if constexpr (RMODE == 2) {
            const int tok = u.pn * BM + 128 * (fr >> 3) + wc * 32 + fq * 8 + (fr & 7);
            const f32x4 p0 = *(const f32x4*)(RSP + (size_t)tok * 16), p1 = *(const f32x4*)(RSP + (size_t)tok * 16 + 4), p2 = *(const f32x4*)(RSP + (size_t)tok * 16 + 8), p3 = *(const f32x4*)(RSP + (size_t)tok * 16 + 12);
            const f32x4 ps = (p0 + p1) + (p2 + p3);
            const float r = 1.f / sqrtf(((ps[0] + ps[1]) + (ps[2] + ps[3])) * (1.f / D) + EPS);
            const int lb = (fq << 4);
#pragma unroll
            for (int j = 0; j < 8; ++j) { r0[j] = __shfl(r, lb + j); r1[j] = __shfl(r, lb + 8 + j); }
        }
#pragma unroll
        for (int ai = 0; ai < 2; ++ai)
#pragma unroll
            for (int m = 0; m < 4; ++m) {
                const int row = u.pm * BM + ai * HALF + wr * 64 + m * 16 + fr, c8 = wc * 32 + fq * 8;
                float a[8], b[8];
#pragma unroll
                for (int j = 0; j < 8; ++j) { a[j] = acc[ai][0][m][j >> 2][j & 3]; b[j] = acc[ai][1][m][j >> 2][j & 3]; }
                if constexpr (RMODE == 0) E(row, u.pn, c8, a, b, 1.f);
                else if constexpr (RMODE == 1) {
                    const f32x4 p = *(const f32x4*)(RSP + (size_t)row * 16 + 4 * fq);
                    float ss = (p[0] + p[1]) + (p[2] + p[3]); ss += __shfl_xor(ss, 16); ss += __shfl_xor(ss, 32);
                    E(row, u.pn, c8, a, b, 1.f / sqrtf(ss * (1.f / D) + EPS));
                } else if constexpr (RMODE == 2) E(row, u.pn, c8, a, b, r0, r1);
                else {
                    float ss = E(row, u.pn, c8, a, b); ss += __shfl_xor(ss, 16); ss += __shfl_xor(ss, 32);
                    if (RSP && fq == 0) RSP[(size_t)row * 16 + u.pn * 4 + wc] = ss;
                }
            }
    }
};
template <class Epi, class Sched, bool ALIGN_EPI = false, bool SP2 = false>
__device__ __forceinline__ void gemm_phase(PG8_LAS unsigned char* lds, const int K, const Sched& S, const Epi& E) {
    const int tid = threadIdx.x, wid = __builtin_amdgcn_readfirstlane(tid >> 6), lane = tid & 63, wr = wid >> 2, wc = wid & 3, fr = lane & 15, fq = lane >> 4;
    const int nt = K / BK;
    unsigned voffA[2], voffB[2];
#pragma unroll
    for (int i = 0; i < 2; ++i) { int R, C; stage_rc(tid * 16 + i * 8192, R, C); const int Rb = Epi::PERM ? ((R & ~31) + perm32(R & 31)) : R;
        voffA[i] = (unsigned)(R * K + C) * 2u; voffB[i] = (unsigned)(Rb * K + C) * 2u; }
    const size_t kstep = (size_t)(BK * 2);
    const size_t hstep = (size_t)HALF * K * 2;
    const size_t tstep = 2 * hstep;
    const unsigned ldsw = (unsigned)wid * 1024u;
    const int aoff = lds_byte(wr * 64 + fr, fq * 8), boff = lds_byte(wc * 32 + fr, fq * 8);
#define PG8_SA(b, h) (((b) * 2 + (h)) * HTB)
#define PG8_SB(b, h) ((4 + (b) * 2 + (h)) * HTB)
#define PG8_STAGE(bufoff, gbase, voff) do { _Pragma("unroll") for (int _i = 0; _i < 2; ++_i) \
        __builtin_amdgcn_global_load_lds((const unsigned*)((const char*)(gbase) + (voff)[_i]), (PG8_LAS unsigned*)(lds + (bufoff) + ldsw + _i * 8192), 16, 0, 0); } while (0)
#define PG8_LDA(dst, b, h) do { _Pragma("unroll") for (int m = 0; m < 4; ++m) _Pragma("unroll") for (int k = 0; k < 2; ++k) dst[m][k] = *(const PG8_LAS bf16x8*)(lds + PG8_SA(b, h) + aoff + m * 2048 + k * 1024); } while (0)
#define PG8_LDB(dst, b, h) do { _Pragma("unroll") for (int n = 0; n < 2; ++n) _Pragma("unroll") for (int k = 0; k < 2; ++k) dst[n][k] = *(const PG8_LAS bf16x8*)(lds + PG8_SB(b, h) + boff + n * 2048 + k * 1024); } while (0)
#define PG8_MMA(ai, bj, At, Bt) do { __builtin_amdgcn_s_setprio(1); _Pragma("unroll") for (int m = 0; m < 4; ++m) _Pragma("unroll") for (int n = 0; n < 2; ++n) _Pragma("unroll") for (int k = 0; k < 2; ++k) \
        acc[ai][bj][m][n] = __builtin_amdgcn_mfma_f32_16x16x32_bf16(Bt[n][k], At[m][k], acc[ai][bj][m][n], 0, 0, 0); __builtin_amdgcn_s_setprio(0); } while (0)
#define PG8_WAIT_V(n) asm volatile("s_waitcnt vmcnt(" #n ")" ::: "memory")
#define PG8_WAIT_L(n) asm volatile("s_waitcnt lgkmcnt(" #n ")" ::: "memory")
#define PG8_BAR __builtin_amdgcn_s_barrier()
#define PG8_SCHED __builtin_amdgcn_sched_barrier(0)
    Unit cur, nxt; int ui = 0;
    if (!S.next(0, cur)) return;
    f32x4 acc[2][2][4][2];
#pragma unroll
    for (int a = 0; a < 2; ++a)
#pragma unroll
        for (int b = 0; b < 2; ++b)
#pragma unroll
            for (int m = 0; m < 4; ++m)
#pragma unroll
                for (int n = 0; n < 2; ++n) acc[a][b][m][n] = (f32x4){0.f, 0.f, 0.f, 0.f};
    bf16x8 At[4][2], B0[2][2], B1[2][2];
    const char* cA = S.tileA(cur, tstep); const char* cB = S.tileB(cur, tstep);
    S.a_ready(cur);
    if constexpr (SP2) {
        PG8_STAGE(PG8_SB(0, 0), cB, voffB); PG8_STAGE(PG8_SB(0, 1), cB + hstep, voffB); PG8_STAGE(PG8_SA(0, 0), cA, voffA); PG8_STAGE(PG8_SA(0, 1), cA + hstep, voffA);
        if (wr == 1) PG8_BAR;
        PG8_WAIT_V(2); PG8_BAR;
        PG8_STAGE(PG8_SB(1, 0), cB + kstep, voffB); PG8_STAGE(PG8_SA(1, 0), cA + kstep, voffA); PG8_STAGE(PG8_SB(1, 1), cB + hstep + kstep, voffB);
        PG8_WAIT_V(6); PG8_BAR;
    } else {
        PG8_STAGE(PG8_SB(0, 0), cB, voffB); PG8_STAGE(PG8_SA(0, 0), cA, voffA); PG8_STAGE(PG8_SB(0, 1), cB + hstep, voffB); PG8_STAGE(PG8_SA(0, 1), cA + hstep, voffA);
        if (wr == 1) PG8_BAR;
        PG8_WAIT_V(4); PG8_BAR;
        PG8_STAGE(PG8_SB(1, 0), cB + kstep, voffB); PG8_STAGE(PG8_SA(1, 0), cA + kstep, voffA); PG8_STAGE(PG8_SB(1, 1), cB + hstep + kstep, voffB);
        PG8_WAIT_V(6); PG8_BAR;
    }
    for (;;) {
        const bool has_next = S.next(ui + 1, nxt);
        const char* nA = has_next ? S.tileA(nxt, tstep) : cA; const char* nB = has_next ? S.tileB(nxt, tstep) : cB;
        for (int t = 0; t < nt; t += 2) {
            const bool last = (t == nt - 2);
            const char* a1 = cA + (size_t)(t + 1) * kstep;
            const char* a2 = last ? nA : cA + (size_t)(t + 2) * kstep; const char* b2 = last ? nB : cB + (size_t)(t + 2) * kstep;
            const char* a3 = a2 + kstep; const char* b3 = b2 + kstep;
            if (last && has_next) S.a_ready(nxt);
            if constexpr (SP2) {
            PG8_LDB(B0, 0, 0); PG8_LDB(B1, 0, 1); PG8_SCHED; PG8_LDA(At, 0, 0); PG8_STAGE(PG8_SA(1, 1), a1 + hstep, voffA);
            PG8_WAIT_V(8); PG8_WAIT_L(0); PG8_BAR; PG8_MMA(0, 0, At, B0); PG8_MMA(0, 1, At, B1); PG8_BAR; PG8_SCHED;
            PG8_LDA(At, 0, 1); PG8_STAGE(PG8_SB(0, 0), b2, voffB); PG8_STAGE(PG8_SB(0, 1), b2 + hstep, voffB); PG8_STAGE(PG8_SA(0, 0), a2, voffA);
            PG8_WAIT_V(8); PG8_WAIT_L(0); PG8_BAR; PG8_MMA(1, 0, At, B0); PG8_MMA(1, 1, At, B1); PG8_BAR; PG8_SCHED;
            PG8_LDB(B0, 1, 0); PG8_LDB(B1, 1, 1); PG8_SCHED; PG8_LDA(At, 1, 0); PG8_STAGE(PG8_SA(0, 1), a2 + hstep, voffA);
            PG8_WAIT_V(8); PG8_WAIT_L(0); PG8_BAR; PG8_MMA(0, 0, At, B0); PG8_MMA(0, 1, At, B1); PG8_BAR; PG8_SCHED;
            PG8_LDA(At, 1, 1); PG8_STAGE(PG8_SB(1, 0), b3, voffB); PG8_STAGE(PG8_SB(1, 1), b3 + hstep, voffB); PG8_STAGE(PG8_SA(1, 0), a3, voffA);
            PG8_WAIT_V(8); PG8_WAIT_L(0); PG8_BAR; PG8_MMA(1, 0, At, B0); PG8_MMA(1, 1, At, B1); PG8_BAR; PG8_SCHED;
            } else {
            PG8_LDB(B0, 0, 0); PG8_SCHED; PG8_LDA(At, 0, 0); PG8_STAGE(PG8_SA(1, 1), a1 + hstep, voffA);
            PG8_WAIT_L(8); PG8_BAR; PG8_WAIT_L(0); PG8_MMA(0, 0, At, B0); PG8_BAR; PG8_SCHED;
            PG8_LDB(B1, 0, 1); PG8_STAGE(PG8_SB(0, 0), b2, voffB);
            PG8_BAR; PG8_WAIT_L(0); PG8_MMA(0, 1, At, B1); PG8_BAR;
            PG8_LDA(At, 0, 1); PG8_STAGE(PG8_SA(0, 0), a2, voffA);
            PG8_BAR; PG8_WAIT_L(0); PG8_MMA(1, 0, At, B0); PG8_BAR; PG8_SCHED;
            PG8_STAGE(PG8_SB(0, 1), b2 + hstep, voffB);
            PG8_WAIT_V(6); PG8_BAR; PG8_MMA(1, 1, At, B1); PG8_BAR;
            PG8_LDB(B0, 1, 0); PG8_SCHED; PG8_LDA(At, 1, 0); PG8_STAGE(PG8_SA(0, 1), a2 + hstep, voffA);
            PG8_WAIT_L(8); PG8_BAR; PG8_WAIT_L(0); PG8_MMA(0, 0, At, B0); PG8_BAR; PG8_SCHED;
            PG8_LDB(B1, 1, 1); PG8_STAGE(PG8_SB(1, 0), b3, voffB);
            PG8_BAR; PG8_WAIT_L(0); PG8_MMA(0, 1, At, B1); PG8_BAR;
            PG8_LDA(At, 1, 1); PG8_STAGE(PG8_SA(1, 0), a3, voffA);
            PG8_BAR; PG8_WAIT_L(0); PG8_MMA(1, 0, At, B0); PG8_BAR; PG8_SCHED;
            PG8_STAGE(PG8_SB(1, 1), b3 + hstep, voffB);
            PG8_WAIT_V(6); PG8_BAR; PG8_MMA(1, 1, At, B1); PG8_BAR;
            }
        }
        if constexpr (ALIGN_EPI) { if (wr == 0) PG8_BAR; }
        if constexpr (!Epi::AFTER_DRAIN) { E(acc, cur, wr, wc, fr, fq); S.done(cur); }
        if (!has_next) break;
#pragma unroll
        for (int a = 0; a < 2; ++a)
#pragma unroll
            for (int b = 0; b < 2; ++b)
#pragma unroll
                for (int m = 0; m < 4; ++m)
#pragma unroll
                    for (int n = 0; n < 2; ++n) acc[a][b][m][n] = (f32x4){0.f, 0.f, 0.f, 0.f};
        cur = nxt; cA = nA; cB = nB; ++ui;
        if constexpr (ALIGN_EPI) { if (wr == 1) PG8_BAR; }
    }
    PG8_WAIT_V(0);
    if constexpr (!ALIGN_EPI) { if (wr == 0) PG8_BAR; }
    PG8_BAR;
    if constexpr (Epi::AFTER_DRAIN) { E.fused(acc, cur, wr, wc, fr, fq, lds, wid, lane); S.done(cur); }
#undef PG8_SA
#undef PG8_SB
#undef PG8_STAGE
#undef PG8_LDA
#undef PG8_LDB
#undef PG8_MMA
#undef PG8_WAIT_V
#undef PG8_WAIT_L
#undef PG8_BAR
#undef PG8_SCHED
}
}

__device__ __forceinline__ void transpose_item(const float* W, int ldw, int col0, const float* g, bf16* WT, int Kd, int n0, int k0, LAS float* scr, int lane) {
    float v[32];
    const float* src = W + (size_t)(k0 + (lane >> 5)) * ldw + col0 + (lane & 31);
#pragma unroll
    for (int i = 0; i < 32; ++i) v[i] = src[(size_t)(2 * i) * ldw];
    const int c = lane & 7;
    f32x4 g0 = (f32x4){1.f, 1.f, 1.f, 1.f}, g1 = g0;
    if (g) { g0 = *(const f32x4*)(g + k0 + 8 * c); g1 = *(const f32x4*)(g + k0 + 8 * c + 4); }
#pragma unroll
    for (int i = 0; i < 32; ++i) scr[(2 * i + (lane >> 5)) * 33 + (lane & 31)] = v[i];
    asm volatile("s_waitcnt lgkmcnt(0)" ::: "memory");
#pragma unroll
    for (int j = 0; j < 4; ++j) { const int n = (lane >> 3) + 8 * j; const LAS float* s = scr + (8 * c) * 33 + n;
        v4u o; o.x = pk2(s[0 * 33] * g0[0], s[1 * 33] * g0[1]); o.y = pk2(s[2 * 33] * g0[2], s[3 * 33] * g0[3]); o.z = pk2(s[4 * 33] * g1[0], s[5 * 33] * g1[1]); o.w = pk2(s[6 * 33] * g1[2], s[7 * 33] * g1[3]);
        *(v4u*)(WT + (size_t)(n0 + n) * Kd + k0 + 8 * c) = o; }
    asm volatile("s_waitcnt lgkmcnt(0)" ::: "memory");
}
template <int NR>
__device__ __forceinline__ void norm_rows_bf16(const float* xrow, const float* gain, bf16* orow, int lane) {
    f32x4 v[NR][4]; float s[NR];
#pragma unroll
    for (int r = 0; r < NR; ++r)
#pragma unroll
        for (int j = 0; j < 4; ++j) v[r][j] = ((const f32x4*)(xrow + (size_t)r * D))[lane + 64 * j];
#pragma unroll
    for (int r = 0; r < NR; ++r) { s[r] = 0.f;
#pragma unroll
        for (int j = 0; j < 4; ++j) s[r] += (v[r][j].x * v[r][j].x + v[r][j].y * v[r][j].y) + (v[r][j].z * v[r][j].z + v[r][j].w * v[r][j].w); }
#pragma unroll
    for (int r = 0; r < NR; ++r) {
        const float rr = 1.f / sqrtf(wave_sum(s[r]) * (1.f / D) + EPS);
        v2u* o8 = (v2u*)(orow + (size_t)r * D) + lane;
#pragma unroll
        for (int j = 0; j < 4; ++j) { f32x4 gg = gain ? ((const f32x4*)gain)[lane + 64 * j] : (f32x4){1.f, 1.f, 1.f, 1.f};
            v2u w; w.x = pk2(v[r][j].x * rr * gg.x, v[r][j].y * rr * gg.y); w.y = pk2(v[r][j].z * rr * gg.z, v[r][j].w * rr * gg.w); o8[64 * j] = w; }
    }
}
__device__ __forceinline__ void p_prologue(const Frame& F) {
    LAS float* scr = (LAS float*)(F.lds + F.wave * 16384);
    unsigned char* ws = F.ws;
    constexpr int I_GU = 16 * (NGU / 32), I_D = (DFF / 64) * (D / 32), I_IN = 16 * (INC / 32), I_SQ = 16 * 32, I_KV = 16 * 64;
    constexpr int NITEMS = 2 * I_GU + 2 * I_D + I_IN + 3 * I_SQ + I_KV;
    for (int it = F.gw; it < NITEMS; it += F.NGW) {
        int r = it;
        if (r < 2 * I_GU) {
            const int which = r / I_GU; r -= which * I_GU; const int nb = r % (NGU / 32), kb = r / (NGU / 32), n0 = 32 * nb, t = n0 / 256, w = n0 % 256, half = w / 128, col = 128 * t + (w % 128);
            const float* W = F.in[(which ? 18 : 3) + half]; const float* g = F.in[which ? 17 : 2];
            transpose_item(W, DFF, col, g, (bf16*)(ws + (which ? WS_WGU2 : WS_WGU1)), D, n0, 64 * kb, scr, F.lane); continue; }
        r -= 2 * I_GU;
        if (r < 2 * I_D) { const int which = r / I_D; r -= which * I_D; const int nb = r % (D / 32), kb = r / (D / 32);
            transpose_item(F.in[which ? 20 : 5], D, 32 * nb, nullptr, (bf16*)(ws + (which ? WS_WD2 : WS_WD1)), DFF, 32 * nb, 64 * kb, scr, F.lane); continue; }
        r -= 2 * I_D;
        if (r < I_IN) { const int nb = r % (INC / 32), kb = r / (INC / 32), n0 = 32 * nb; int col = n0;
            if (n0 >= 2560) { const int t = (n0 - 2560) / 256, w = (n0 - 2560) % 256, half = w / 128; col = (half ? 3072 : 2560) + 128 * t + (w % 128); }
            transpose_item(F.in[7], INC, col, F.in[6], (bf16*)(ws + WS_WIN), D, n0, 64 * kb, scr, F.lane); continue; }
        r -= I_IN;
        if (r < 3 * I_SQ) { const int which = r / I_SQ; r -= which * I_SQ; const int nb = r % 32, kb = r / 32;
            const float* W = F.in[which == 0 ? 11 : (which == 1 ? 14 : 16)]; const float* g = which == 1 ? F.in[12] : nullptr;
            bf16* dst = (bf16*)(ws + (which == 0 ? WS_WOUT : (which == 1 ? WS_WQ : WS_WO)));
            transpose_item(W, D, 32 * nb, g, dst, D, 32 * nb, 64 * kb, scr, F.lane); continue; }
        r -= 3 * I_SQ;
        { const int nb = r % 64, kb = r / 64; transpose_item(F.in[15], 2 * D, 32 * nb, nullptr, (bf16*)(ws + WS_WKV), D, 32 * nb, 64 * kb, scr, F.lane); }
    }
    for (int m = 4 * F.gw; m < M; m += 4 * F.NGW) norm_rows_bf16<4>(F.in[0] + (size_t)m * D, nullptr, (bf16*)(ws + WS_XN) + (size_t)m * D, F.lane);
    for (int m = F.gw; m < MROWS; m += F.NGW) norm_rows_bf16<1>(F.in[1] + (size_t)m * D, F.in[13], (bf16*)(ws + WS_MN) + (size_t)m * D, F.lane);
    if (F.gtid < HF) { const float p0 = F.in[8][F.gtid], p1 = F.in[8][HF + F.gtid]; const float mx = fmaxf(p0, p1), e0 = __expf(p0 - mx), e1 = __expf(p1 - mx);
        ((float*)(ws + WS_LB))[F.gtid] = e0 / (e0 + e1); }
}

__device__ __forceinline__ void p_final(const Frame& F) {
    const float* g = F.in[21];
    for (int m = F.gw; m < M; m += F.NGW) {
        f32x4* xr = (f32x4*)(F.out + (size_t)m * D) + F.lane; f32x4 v[4]; float s = 0.f;
#pragma unroll
        for (int j = 0; j < 4; ++j) { v[j] = xr[64 * j]; s += (v[j].x * v[j].x + v[j].y * v[j].y) + (v[j].z * v[j].z + v[j].w * v[j].w); }
        const float r = 1.f / sqrtf(wave_sum(s) * (1.f / D) + EPS);
#pragma unroll
        for (int j = 0; j < 4; ++j) { const f32x4 gg = ((const f32x4*)g)[F.lane + 64 * j]; xr[64 * j] = (f32x4){v[j].x * r * gg.x, v[j].y * r * gg.y, v[j].z * r * gg.z, v[j].w * r * gg.w}; }
    }
}

__device__ __forceinline__ void p_conv(const Frame& F) {
    const bf16* ZB = (const bf16*)(F.ws + WS_ZB); const bf16* P = (const bf16*)(F.ws + WS_P); bf16* Y = (bf16*)(F.ws + WS_Y); const float* cw = F.in[10];
    const long nitem = (long)M * 64;
    for (long i = F.gtid; i < nitem; i += F.NT) {
        const int row = (int)(i >> 6), c8 = (int)(i & 63) * 8, t = row % SEQ;
        float zb[8], p0[8], p1[8], p2[8], o[8];
        unpack8(*(const v4u*)(ZB + (size_t)row * 512 + c8), zb);
        unpack8(*(const v4u*)(P + (size_t)row * 512 + c8), p2);
        if (t >= 1) unpack8(*(const v4u*)(P + (size_t)(row - 1) * 512 + c8), p1); else {
#pragma unroll
            for (int j = 0; j < 8; ++j) p1[j] = 0.f; }
        if (t >= 2) unpack8(*(const v4u*)(P + (size_t)(row - 2) * 512 + c8), p0); else {
#pragma unroll
            for (int j = 0; j < 8; ++j) p0[j] = 0.f; }
#pragma unroll
        for (int j = 0; j < 8; ++j) { const float* w = cw + (c8 + j) * 3; o[j] = zb[j] * (w[0] * p0[j] + w[1] * p1[j] + w[2] * p2[j]); }
        *(v4u*)(Y + (size_t)row * D + 512 + c8) = pack8(o);
    }
}

typedef short bf16x8 __attribute__((ext_vector_type(8)));
typedef short bf16x4 __attribute__((ext_vector_type(4)));
#define MFMA16(a, b, c) __builtin_amdgcn_mfma_f32_16x16x32_bf16((a), (b), (c), 0, 0, 0)
__device__ __forceinline__ v2u pk4(f32x4 v) { v2u w; w.x = pk2(v[0], v[1]); w.y = pk2(v[2], v[3]); return w; }

struct ChunkRegs { f32x4 lf[4]; v4u kw[2]; v4u qw[2]; v4u vw[2]; };
template <bool WITH_Q>
__device__ __forceinline__ void chunk_load(ChunkRegs& R, const unsigned char* ws, int u, int dk, int sq) {
    const int c = u & 63, h = (u >> 6) & 3, b = u >> 8;
    const size_t roff = (size_t)(h * 128 + dk) * M + (size_t)b * SEQ + c * 64 + sq * 16;
    const float* LOGFT = (const float*)(ws + WS_LOGF) + roff; const bf16* KT = (const bf16*)(ws + WS_KK) + roff; const bf16* VT = (const bf16*)(ws + WS_V) + roff; const bf16* QT = (const bf16*)(ws + WS_Q) + roff;
#pragma unroll
    for (int i = 0; i < 4; ++i) R.lf[i] = *(const f32x4*)(LOGFT + 4 * i);
#pragma unroll
    for (int i = 0; i < 2; ++i) { R.kw[i] = *(const v4u*)(KT + 8 * i); R.vw[i] = *(const v4u*)(VT + 8 * i); if (WITH_Q) R.qw[i] = *(const v4u*)(QT + 8 * i); }
}
__device__ __forceinline__ float chunk_cumsum(const ChunkRegs& R, int lane, int sq, float (&bt)[16]) {
    float run = 0.f;
#pragma unroll
    for (int i = 0; i < 16; ++i) { run += R.lf[i >> 2][i & 3]; bt[i] = run; }
    const int base = lane & ~3;
    const float t0 = __shfl(run, base), t1 = __shfl(run, base + 1), t2 = __shfl(run, base + 2), t3 = __shfl(run, base + 3);
    const float pre = (sq > 0 ? t0 : 0.f) + (sq > 1 ? t1 : 0.f) + (sq > 2 ? t2 : 0.f);
#pragma unroll
    for (int i = 0; i < 16; ++i) bt[i] += pre;
    return (t0 + t1) + (t2 + t3);
}
constexpr int NUNIT = BATCH * NH * NCHUNK;
__device__ __forceinline__ void p_scanA(const Frame& F) {
    unsigned char* ws = F.ws; bf16* DS = (bf16*)(ws + WS_DS); float* DEC = (float*)(ws + WS_DEC);
    LAS unsigned char* KhT = F.lds; LAS unsigned char* VTl = F.lds + 18432;
    const int tid = F.tid, lane = F.lane, w = F.wave, dk = tid >> 2, sq = tid & 3, i16 = lane & 15, q4 = lane >> 4;
    ChunkRegs R;
    int u = F.vcu; if (u < NUNIT) chunk_load<false>(R, ws, u, dk, sq);
    for (; u < NUNIT; u += F.G) {
        float bt[16]; const float tot = chunk_cumsum(R, lane, sq, bt);
        float kf[16]; { float t8[8]; unpack8(R.kw[0], t8);
#pragma unroll
            for (int j = 0; j < 8; ++j) kf[j] = t8[j]; unpack8(R.kw[1], t8);
#pragma unroll
            for (int j = 0; j < 8; ++j) kf[8 + j] = t8[j]; }
        float o0[8], o1[8];
#pragma unroll
        for (int j = 0; j < 8; ++j) { o0[j] = kf[j] * __expf(tot - bt[j]); o1[j] = kf[8 + j] * __expf(tot - bt[8 + j]); }
        *(LAS v4u*)(KhT + dk * 144 + sq * 32) = pack8(o0); *(LAS v4u*)(KhT + dk * 144 + sq * 32 + 16) = pack8(o1);
        *(LAS v4u*)(VTl + dk * 144 + sq * 32) = R.vw[0]; *(LAS v4u*)(VTl + dk * 144 + sq * 32 + 16) = R.vw[1];
        if (sq == 0) DEC[(size_t)u * 128 + dk] = __expf(tot);
        __syncthreads();
        if (u + F.G < NUNIT) chunk_load<false>(R, ws, u + F.G, dk, sq);
        const bf16x8 a0 = *(const LAS bf16x8*)(KhT + (16 * w + i16) * 144 + q4 * 16), a1 = *(const LAS bf16x8*)(KhT + (16 * w + i16) * 144 + 64 + q4 * 16);
#pragma unroll
        for (int dvb = 0; dvb < 8; ++dvb) {
            const bf16x8 b0 = *(const LAS bf16x8*)(VTl + (16 * dvb + i16) * 144 + q4 * 16), b1 = *(const LAS bf16x8*)(VTl + (16 * dvb + i16) * 144 + 64 + q4 * 16);
            f32x4 acc = (f32x4){0.f, 0.f, 0.f, 0.f};
            acc = MFMA16(a0, b0, acc); acc = MFMA16(a1, b1, acc);
            *(v2u*)(DS + (size_t)u * 16384 + (16 * dvb + i16) * 128 + 16 * w + 4 * q4) = pk4(acc);
        }
        __syncthreads();
    }
}
__device__ __forceinline__ void p_scanB(const Frame& F) {
    unsigned* DSu = (unsigned*)(F.ws + WS_DS); const float* DEC = (const float*)(F.ws + WS_DEC);
    for (long e = F.gtid; e < (long)BATCH * NH * 8192; e += F.NT) {
        const int bh = (int)(e >> 13), pr = (int)(e & 8191), dk = (2 * pr) & 127;
        unsigned* p = DSu + (size_t)bh * 64 * 8192 + pr; const float* dec = DEC + (size_t)bh * 64 * 128 + dk;
        float S0 = 0.f, S1 = 0.f;
        for (int c0 = 0; c0 < NCHUNK; c0 += 16) {
            unsigned wv[16]; float d0[16], d1[16];
#pragma unroll
            for (int j = 0; j < 16; ++j) { wv[j] = p[(size_t)(c0 + j) * 8192]; d0[j] = dec[(c0 + j) * 128]; d1[j] = dec[(c0 + j) * 128 + 1]; }
#pragma unroll
            for (int j = 0; j < 16; ++j) { p[(size_t)(c0 + j) * 8192] = pk2(S0, S1); S0 = d0[j] * S0 + bflo(wv[j]); S1 = d1[j] * S1 + bfhi(wv[j]); }
        }
    }
}
constexpr int LC_QS = 0, LC_KS = 17408, LC_VT = 34816, LC_P = 53248, LC_ST = 62464, LC_RED = 97280;
__device__ __forceinline__ void p_scanC(const Frame& F) {
    unsigned char* ws = F.ws; const bf16* DS = (const bf16*)(ws + WS_DS); const bf16* SG = (const bf16*)(ws + WS_SG); bf16* Y = (bf16*)(ws + WS_Y); const float* gh = F.in[9];
    LAS unsigned char* L = F.lds;
    const int tid = F.tid, lane = F.lane, w = F.wave, dk = tid >> 2, sq = tid & 3, i16 = lane & 15, q4 = lane >> 4;
    ChunkRegs R; v4u st[4];
    int u = F.vcu;
    if (u < NUNIT) { chunk_load<true>(R, ws, u, dk, sq);
#pragma unroll
        for (int i = 0; i < 4; ++i) { const int p = tid + 512 * i; st[i] = *(const v4u*)(DS + (size_t)u * 16384 + (p >> 4) * 128 + (p & 15) * 8); } }
    for (; u < NUNIT; u += F.G) {
        const int c = u & 63, h = (u >> 6) & 3, b = u >> 8;
        float bt[16]; (void)chunk_cumsum(R, lane, sq, bt);
        { float kf[8], qf[8];
#pragma unroll
          for (int hh = 0; hh < 2; ++hh) { unpack8(R.kw[hh], kf); unpack8(R.qw[hh], qf);
#pragma unroll
            for (int j = 0; j < 8; ++j) { const int t = 16 * sq + 8 * hh + j; const float e = __expf(bt[8 * hh + j]);
                const int off = t * 272 + ((dk >> 3) ^ (2 * sq)) * 16 + (dk & 7) * 2;
                *(LAS bf16*)(L + LC_QS + off) = (bf16)f2bf(qf[j] * e); *(LAS bf16*)(L + LC_KS + off) = (bf16)f2bf(kf[j] / e); } } }
        *(LAS v4u*)(L + LC_VT + dk * 144 + sq * 32) = R.vw[0]; *(LAS v4u*)(L + LC_VT + dk * 144 + sq * 32 + 16) = R.vw[1];
#pragma unroll
        for (int i = 0; i < 4; ++i) { const int p = tid + 512 * i; *(LAS v4u*)(L + LC_ST + (p >> 4) * 272 + (p & 15) * 16) = st[i]; }
        __syncthreads();
        if (u + F.G < NUNIT) { chunk_load<true>(R, ws, u + F.G, dk, sq);
#pragma unroll
            for (int i = 0; i < 4; ++i) { const int p = tid + 512 * i; st[i] = *(const v4u*)(DS + (size_t)(u + F.G) * 16384 + (p >> 4) * 128 + (p & 15) * 8); } }
        const int row0 = b * SEQ + c * 64, col = h * 128 + 16 * w + 4 * q4;
        v2u sgw[4];
#pragma unroll
        for (int tb = 0; tb < 4; ++tb) sgw[tb] = *(const v2u*)(SG + (size_t)(row0 + 16 * tb + i16) * 512 + col);
        { const int tb = w & 3, sb0 = 2 * (w >> 2);
          f32x4 a0 = (f32x4){0.f, 0.f, 0.f, 0.f}, a1 = a0;
#pragma unroll
          for (int ks = 0; ks < 4; ++ks) {
              const bf16x8 qb = *(const LAS bf16x8*)(L + LC_QS + (16 * tb + i16) * 272 + (((4 * ks + q4) ^ (2 * tb)) * 16));
              const bf16x8 k0 = *(const LAS bf16x8*)(L + LC_KS + (16 * sb0 + i16) * 272 + (((4 * ks + q4) ^ (2 * sb0)) * 16));
              const bf16x8 k1 = *(const LAS bf16x8*)(L + LC_KS + (16 * (sb0 + 1) + i16) * 272 + (((4 * ks + q4) ^ (2 * (sb0 + 1))) * 16));
              a0 = MFMA16(k0, qb, a0); a1 = MFMA16(k1, qb, a1); }
          const int t = 16 * tb + i16;
#pragma unroll
          for (int r = 0; r < 4; ++r) { if (16 * sb0 + 4 * q4 + r > t) a0[r] = 0.f; if (16 * (sb0 + 1) + 4 * q4 + r > t) a1[r] = 0.f; }
          *(LAS v2u*)(L + LC_P + t * 144 + (16 * sb0 + 4 * q4) * 2) = pk4(a0); *(LAS v2u*)(L + LC_P + t * 144 + (16 * (sb0 + 1) + 4 * q4) * 2) = pk4(a1); }
        __syncthreads();
        f32x4 o[4];
        { bf16x8 av[2], as[4];
#pragma unroll
          for (int ks = 0; ks < 2; ++ks) av[ks] = *(const LAS bf16x8*)(L + LC_VT + (16 * w + i16) * 144 + ks * 64 + q4 * 16);
#pragma unroll
          for (int ks = 0; ks < 4; ++ks) as[ks] = *(const LAS bf16x8*)(L + LC_ST + (16 * w + i16) * 272 + (4 * ks + q4) * 16);
#pragma unroll
          for (int tb = 0; tb < 4; ++tb) {
              f32x4 acc = (f32x4){0.f, 0.f, 0.f, 0.f};
#pragma unroll
              for (int ks = 0; ks < 2; ++ks) if (ks == 0 || tb >= 2) acc = MFMA16(av[ks], *(const LAS bf16x8*)(L + LC_P + (16 * tb + i16) * 144 + ks * 64 + q4 * 16), acc);
#pragma unroll
              for (int ks = 0; ks < 4; ++ks) acc = MFMA16(as[ks], *(const LAS bf16x8*)(L + LC_QS + (16 * tb + i16) * 272 + (((4 * ks + q4) ^ (2 * tb)) * 16)), acc);
              o[tb] = acc;
              float ss = (acc[0] * acc[0] + acc[1] * acc[1]) + (acc[2] * acc[2] + acc[3] * acc[3]);
              ss += __shfl_xor(ss, 16); ss += __shfl_xor(ss, 32);
              if (q4 == 0) *(LAS float*)(L + LC_RED + (w * 64 + 16 * tb + i16) * 4) = ss;
          } }
        __syncthreads();
        const f32x4 gv = *(const f32x4*)(gh + col);
#pragma unroll
        for (int tb = 0; tb < 4; ++tb) {
            float tot = 0.f;
#pragma unroll
            for (int ww = 0; ww < 8; ++ww) tot += *(const LAS float*)(L + LC_RED + (ww * 64 + 16 * tb + i16) * 4);
            const float rr = 1.f / sqrtf(tot * (1.f / DV) + EPS);
            v2u yo; yo.x = pk2(o[tb][0] * rr * gv[0] * bflo(sgw[tb].x), o[tb][1] * rr * gv[1] * bfhi(sgw[tb].x)); yo.y = pk2(o[tb][2] * rr * gv[2] * bflo(sgw[tb].y), o[tb][3] * rr * gv[3] * bfhi(sgw[tb].y));
            *(v2u*)(Y + (size_t)(row0 + 16 * tb + i16) * D + col) = yo;
        }
        __syncthreads();
    }
}


constexpr int ATT_BUF = 36864;
__device__ __forceinline__ void att_stage_load(v4u (&pre)[4], const unsigned char* ws, int b, int h, int st, int tid) {
    if (st < 4) {
        const bf16* KM = (const bf16*)(ws + WS_KM) + (size_t)(b * MEML + 64 * st) * D + h * MHD;
#pragma unroll
        for (int i = 0; i < 4; ++i) { const int p = tid + 512 * i; pre[i] = *(const v4u*)(KM + (size_t)(p >> 5) * D + (p & 31) * 8); }
    } else {
        const int hp = (st - 4) >> 2, vc = (st - 4) & 3;
        const bf16* VMT = (const bf16*)(ws + WS_VMT) + (size_t)(h * MHD + 128 * hp) * MROWS + b * MEML + 64 * vc;
#pragma unroll
        for (int i = 0; i < 2; ++i) { const int p = tid + 512 * i; pre[i] = *(const v4u*)(VMT + (size_t)(p >> 3) * MROWS + (p & 7) * 8); }
    }
}
__device__ __forceinline__ void att_stage_write(const v4u (&pre)[4], LAS unsigned char* buf, int st, int tid) {
    if (st < 4) {
#pragma unroll
        for (int i = 0; i < 4; ++i) { const int p = tid + 512 * i; *(LAS v4u*)(buf + (p >> 5) * 528 + (p & 31) * 16) = pre[i]; }
    } else {
#pragma unroll
        for (int i = 0; i < 2; ++i) { const int p = tid + 512 * i; *(LAS v4u*)(buf + (p >> 3) * 144 + (p & 7) * 16) = pre[i]; }
    }
}
__device__ __forceinline__ void p_attn(const Frame& F) {
    unsigned char* ws = F.ws; const bf16* QM = (const bf16*)(ws + WS_QM); bf16* ATT = (bf16*)(ws + WS_ATT);
    const int tid = F.tid, lane = F.lane, w = F.wave, i16 = lane & 15, q4 = lane >> 4;
    for (int u = F.vcu; u < BATCH * MH * (SEQ / 256); u += F.G) {
        const int tblk = u & 15, h = (u >> 4) & 3, b = u >> 6;
        const int tok0 = b * SEQ + tblk * 256 + 32 * w;
        v4u pre[4];
        att_stage_load(pre, ws, b, h, 0, tid);
        const bf16* qp = QM + (size_t)(tok0 + i16) * D + h * MHD + 8 * q4;
        att_stage_write(pre, F.lds, 0, tid);
        __syncthreads();
        f32x4 S[16][2];
#pragma unroll
        for (int i = 0; i < 16; ++i) { S[i][0] = (f32x4){0.f, 0.f, 0.f, 0.f}; S[i][1] = S[i][0]; }
#pragma unroll
        for (int st = 0; st < 4; ++st) {
            att_stage_load(pre, ws, b, h, st + 1, tid);
            LAS unsigned char* buf = F.lds + (st & 1) * ATT_BUF;
#pragma unroll
            for (int ks = 0; ks < 8; ++ks) {
                const bf16x8 q0 = *(const bf16x8*)(qp + 32 * ks), q1 = *(const bf16x8*)(qp + 16 * D + 32 * ks);
#pragma unroll
                for (int mt = 0; mt < 4; ++mt) {
                    const bf16x8 kf = *(const LAS bf16x8*)(buf + (16 * mt + i16) * 528 + (32 * ks + 8 * q4) * 2);
                    S[4 * st + mt][0] = MFMA16(kf, q0, S[4 * st + mt][0]); S[4 * st + mt][1] = MFMA16(kf, q1, S[4 * st + mt][1]);
                }
            }
            att_stage_write(pre, F.lds + ((st + 1) & 1) * ATT_BUF, st + 1, tid);
            __syncthreads();
        }
        bf16x8 pf[8][2]; float inv[2];
#pragma unroll
        for (int tt = 0; tt < 2; ++tt) {
            float mx = -3.0e38f;
#pragma unroll
            for (int i = 0; i < 16; ++i) mx = fmaxf(mx, fmaxf(fmaxf(S[i][tt][0], S[i][tt][1]), fmaxf(S[i][tt][2], S[i][tt][3])));
            mx = fmaxf(mx, __shfl_xor(mx, 16)); mx = fmaxf(mx, __shfl_xor(mx, 32));
            float l = 0.f;
#pragma unroll
            for (int k2 = 0; k2 < 8; ++k2) {
                float e[8];
#pragma unroll
                for (int r = 0; r < 4; ++r) { e[r] = __expf(S[2 * k2][tt][r] - mx); e[4 + r] = __expf(S[2 * k2 + 1][tt][r] - mx); }
#pragma unroll
                for (int r = 0; r < 8; ++r) l += e[r];
                pf[k2][tt] = __builtin_bit_cast(bf16x8, pack8(e));
            }
            l += __shfl_xor(l, 16); l += __shfl_xor(l, 32);
            inv[tt] = 1.f / l;
        }
#pragma unroll
        for (int hp = 0; hp < 2; ++hp) {
            f32x4 O[8][2];
#pragma unroll
            for (int i = 0; i < 8; ++i) { O[i][0] = (f32x4){0.f, 0.f, 0.f, 0.f}; O[i][1] = O[i][0]; }
#pragma unroll
            for (int vc = 0; vc < 4; ++vc) {
                const int st = 4 + 4 * hp + vc;
                if (st < 11) att_stage_load(pre, ws, b, h, st + 1, tid);
                LAS unsigned char* buf = F.lds + (st & 1) * ATT_BUF;
#pragma unroll
                for (int k2 = 0; k2 < 2; ++k2)
#pragma unroll
                    for (int hdt = 0; hdt < 8; ++hdt) {
                        const bf16x4 lo = *(const LAS bf16x4*)(buf + (16 * hdt + i16) * 144 + (32 * k2 + 4 * q4) * 2), hi = *(const LAS bf16x4*)(buf + (16 * hdt + i16) * 144 + (32 * k2 + 16 + 4 * q4) * 2);
                        const bf16x8 vf = __builtin_shufflevector(lo, hi, 0, 1, 2, 3, 4, 5, 6, 7);
                        O[hdt][0] = MFMA16(vf, pf[2 * vc + k2][0], O[hdt][0]); O[hdt][1] = MFMA16(vf, pf[2 * vc + k2][1], O[hdt][1]);
                    }
                if (st < 11) att_stage_write(pre, F.lds + ((st + 1) & 1) * ATT_BUF, st + 1, tid);
                __syncthreads();
            }
#pragma unroll
            for (int tt = 0; tt < 2; ++tt)
#pragma unroll
                for (int hdt = 0; hdt < 8; ++hdt) {
                    const f32x4 v = O[hdt][tt] * inv[tt];
                    *(v2u*)(ATT + (size_t)(tok0 + 16 * tt + i16) * D + h * MHD + 128 * hp + 16 * hdt + 4 * q4) = pk4(v);
                }
        }
    }
}

#define GEMM1(multi, rmode, Ap, Bp, Mr, Nn, Kk, EmT, emv, rsp) GEMM1C(multi, rmode, (int)blockIdx.x, Ap, Bp, Mr, Nn, Kk, EmT, emv, rsp)
#define GEMM1C(multi, rmode, cc, Ap, Bp, Mr, Nn, Kk, EmT, emv, rsp) do { \
        pg8::Sched1 S_{(Ap), (Bp), (Mr) / 256, (Nn) / 256, F.G, (cc)}; pg8::EpiEmit<EmT, rmode> E_{emv, (rsp)}; \
        pg8::gemm_phase<pg8::EpiEmit<EmT, rmode>, pg8::Sched1, multi, true>(F.lds, (Kk), S_, E_); } while (0)

struct Args { const float* in[22]; float* out; unsigned char* ws; int ph_lo, ph_hi; };
__global__ void __launch_bounds__(NTHR, 2) fwd(Args args) {
    extern __shared__ __attribute__((aligned(16))) unsigned char lds[];
    Frame F;
    F.lds = (LAS unsigned char*)lds;
    F.tid = threadIdx.x; F.lane = F.tid & 63; F.wave = __builtin_amdgcn_readfirstlane(F.tid >> 6);
    F.G = gridDim.x; { const int bx = blockIdx.x; F.vcu = (F.G % 8 == 0) ? (bx % 8) * (F.G / 8) + bx / 8 : bx; }
    F.gtid = (long)F.vcu * NTHR + F.tid; F.NT = (long)F.G * NTHR; F.gw = F.vcu * NWAVES + F.wave; F.NGW = F.G * NWAVES;
    F.in = args.in;
    F.out = args.out; F.ws = args.ws;
    unsigned char* ws = args.ws;
    const int lo = args.ph_lo, hi = args.ph_hi;
    for (int u = F.tid; u < (LDS_BYTES - LDSCTL_OFF) / 4; u += NTHR) ((LAS unsigned*)(F.lds + LDSCTL_OFF))[u] = 0u;
    __syncthreads();
    XcdBarrier bar; bar.bar = (unsigned*)(ws + WS_CTL) + CW_BAR; bar.x = 0; bar.st = nullptr;
    if (hi - lo > 1) bar = xcd_barrier_post((unsigned*)(ws + WS_CTL) + CW_BAR, (volatile LAS unsigned*)(F.lds + MISC_OFF) + 8);
#define IN(k) (lo <= (k) && (k) < hi)
#define SEAM(k) do { if (IN(k) && IN((k) + 1)) xcd_barrier(bar); } while (0)
    float* RSP = (float*)(ws + WS_RSP);
    if (IN(0)) p_prologue(F);
    SEAM(0);
    if (IN(1)) {
        GEMM1(true, 0, (const bf16*)(ws + WS_XN), (const bf16*)(ws + WS_WGU1), M, NGU, D, EmGU, (EmGU{(bf16*)(ws + WS_HID)}), nullptr);
        GEMM1C(false, 0, (int)blockIdx.x - 128, (const bf16*)(ws + WS_MN), (const bf16*)(ws + WS_WKV), MROWS, D, D, EmPlain, (EmPlain{(bf16*)(ws + WS_KM), 1.f}), nullptr);
        GEMM1C(false, 0, (int)blockIdx.x - 144, (const bf16*)(ws + WS_WKV) + (size_t)D * D, (const bf16*)(ws + WS_MN), D, MROWS, D, EmPlain, (EmPlain{(bf16*)(ws + WS_VMT), 1.f}), nullptr);
    }
    SEAM(1);
    if (IN(2)) GEMM1(false, 3, (const bf16*)(ws + WS_HID), (const bf16*)(ws + WS_WD1), M, D, DFF, EmRes, (EmRes{F.in[0], F.out, (bf16*)(ws + WS_XB), 0.5f}), RSP);
    SEAM(2);
    if (IN(3)) {
        GEMM1(true, 1, (const bf16*)(ws + WS_XB), (const bf16*)(ws + WS_WIN) + (size_t)1536 * D, M, 2048, D, EmInA, (EmInA{(bf16*)(ws + WS_SG), (bf16*)(ws + WS_ZB), (bf16*)(ws + WS_P)}), RSP);
        GEMM1(true, 2, (const bf16*)(ws + WS_WIN), (const bf16*)(ws + WS_XB), 1536, M, D, EmInB,
              (EmInB{(bf16*)(ws + WS_Q), (bf16*)(ws + WS_KK), (bf16*)(ws + WS_V), (float*)(ws + WS_LOGF), (const float*)(ws + WS_LB)}), RSP);
    }
    SEAM(3);
    if (IN(4)) { p_conv(F); p_scanA(F); }
    SEAM(4);
    if (IN(5)) p_scanB(F);
    SEAM(5);
    if (IN(6)) p_scanC(F);
    SEAM(6);
    if (IN(7)) GEMM1(false, 3, (const bf16*)(ws + WS_Y), (const bf16*)(ws + WS_WOUT), M, D, D, EmRes, (EmRes{F.out, F.out, (bf16*)(ws + WS_XB2), 1.f}), RSP);
    SEAM(7);
    if (IN(8)) GEMM1(false, 1, (const bf16*)(ws + WS_XB2), (const bf16*)(ws + WS_WQ), M, D, D, EmPlain, (EmPlain{(bf16*)(ws + WS_QM), 0.0625f}), RSP);
    SEAM(8);
    if (IN(9)) p_attn(F);
    SEAM(9);
    if (IN(10)) GEMM1(false, 3, (const bf16*)(ws + WS_ATT), (const bf16*)(ws + WS_WO), M, D, D, EmRes, (EmRes{F.out, F.out, (bf16*)(ws + WS_XB2), 1.f}), RSP);
    SEAM(10);
    if (IN(11)) GEMM1(true, 1, (const bf16*)(ws + WS_XB2), (const bf16*)(ws + WS_WGU2), M, NGU, D, EmGU, (EmGU{(bf16*)(ws + WS_HID)}), RSP);
    SEAM(11);
    if (IN(12)) GEMM1(false, 3, (const bf16*)(ws + WS_HID), (const bf16*)(ws + WS_WD2), M, D, DFF, EmRes, (EmRes{F.out, F.out, nullptr, 0.5f}), nullptr);
    SEAM(12);
    if (IN(13)) p_final(F);
#undef IN
#undef SEAM
}

extern "C" void kernel_launch(void* const* d_in, const int* in_sizes, int n_in, void* d_out, int out_size, void* d_ws, size_t ws_size, hipStream_t stream) {
    static int grid = 0;
    if (grid == 0) {
        if (n_in != 22 || in_sizes[0] != M * D || out_size != M * D || ws_size < WS_END) { fprintf(stderr, "kernel_launch: unexpected shapes (n_in %d, in0 %d, out %d, ws %zu)\n", n_in, n_in > 0 ? in_sizes[0] : -1, out_size, ws_size); grid = -1; return; }
        int dev = 0, cus = 0;
        if (hipGetDevice(&dev) != hipSuccess || hipDeviceGetAttribute(&cus, hipDeviceAttributeMultiprocessorCount, dev) != hipSuccess) { grid = -1; return; }
        if (hipFuncSetAttribute((const void*)fwd, hipFuncAttributeMaxDynamicSharedMemorySize, LDS_BYTES) != hipSuccess) { fprintf(stderr, "kernel_launch: hipFuncSetAttribute failed\n"); grid = -1; return; }
        grid = cus;
    }
    if (grid < 0) return;
    Args a{};
    for (int i = 0; i < 22; ++i) a.in[i] = (const float*)d_in[i];
    a.out = (float*)d_out; a.ws = (unsigned char*)d_ws;
    if (hipMemsetAsync((char*)d_ws + WS_CTL, 0, CTL_ZERO_BYTES, stream) != hipSuccess) { fprintf(stderr, "kernel_launch: memset failed\n"); return; }
    a.ph_lo = 0; a.ph_hi = NPHASE;
    void* kargs[] = {&a};
    hipError_t e = hipLaunchCooperativeKernel((const void*)fwd, dim3(grid), dim3(NTHR), kargs, LDS_BYTES, stream);
    if (e != hipSuccess) fprintf(stderr, "kernel_launch: cooperative launch failed: %s (grid %d)\n", hipGetErrorString(e), grid);
}
```
